# Optimizing an MI355X kernel written in HIP

```python
import math
import jax
import jax.numpy as jnp
from jax import lax
import numpy as np

D_MODEL = 1024
BATCH = 2
SEQ = 8192
DEPTH = 4

GRID_W = 64
CTX_LEN = 256
N_MIXERS = 3
N_A_LAYERS = (DEPTH + 2) // 3
N_B_LAYERS = (DEPTH + 1) // 3
N_C_LAYERS = DEPTH // 3
D_FF = 2816
N_MOD = 9
RMS_EPS = 1e-6
ROPE_BASE = 10000.0
Q_BLOCK = 128

A_HEADS = 8
A_Q_LORA = 256
A_KV_LORA = 128
A_NOPE = 128
A_ROPE = 64
A_V = 128
A_IN = A_Q_LORA + A_KV_LORA + A_ROPE

B_HEADS = 8
B_HEAD = D_MODEL // (2 * B_HEADS)

C_HEADS = 16
C_HEAD = D_MODEL // C_HEADS
C_WIN_H = 8
C_WIN_W = 16

kernel_name = 'hybrid_mla_diff_natten_macaron_dit'


def rmsnorm(x, g):
    xf = x.astype(jnp.float32)
    y = xf * lax.rsqrt(jnp.mean(xf * xf, axis=-1, keepdims=True) + RMS_EPS)
    return (y * g.astype(jnp.float32)).astype(x.dtype)


def modulation(cond, w_mod, b_mod):
    m = jax.nn.silu(cond) @ w_mod + b_mod
    return m.reshape(cond.shape[0], N_MOD, D_MODEL)


def modulate(x, g, shift, scale):
    return rmsnorm(x, g) * (1.0 + scale[:, None]) + shift[:, None]


def swiglu(h, w_gate, w_up, w_down):
    return (jax.nn.silu(h @ w_gate) * (h @ w_up)) @ w_down


def macaron_half(s, m, base, g, w_gate, w_up, w_down):
    h = modulate(s, g, m[:, base], m[:, base + 1])
    return s + 0.5 * m[:, base + 2, None] * swiglu(h, w_gate, w_up, w_down)


def axial_rope_angles(n_tokens, rot_dim):
    t = jnp.arange(n_tokens, dtype=jnp.int32)
    row = (t // GRID_W).astype(jnp.float32)
    col = (t % GRID_W).astype(jnp.float32)
    axis_dim = rot_dim // 2
    inv = ROPE_BASE ** (-jnp.arange(0, axis_dim, 2, dtype=jnp.float32) / axis_dim)
    ang = jnp.concatenate([row[:, None] * inv, col[:, None] * inv], axis=-1)
    return jnp.cos(ang), jnp.sin(ang)


def apply_rope(x, cos, sin):
    half = x.shape[-1] // 2
    shape = (1, cos.shape[0], 1, half)
    c, s = cos.reshape(shape), sin.reshape(shape)
    xf = x.astype(jnp.float32)
    x1, x2 = xf[..., :half], xf[..., half:]
    return jnp.concatenate([x1 * c - x2 * s, x1 * s + x2 * c], axis=-1).astype(x.dtype)


def attend(q, k, v, scale):
    s = jnp.einsum('bqhd,bkhd->bhqk', q, k) * scale
    p = jax.nn.softmax(s.astype(jnp.float32), axis=-1).astype(v.dtype)
    return jnp.einsum('bhqk,bkhd->bqhd', p, v)


def query_blocks(fn, q):
    b, n = q.shape[:2]
    nb = n // Q_BLOCK
    qb = jnp.moveaxis(q.reshape((b, nb, Q_BLOCK) + q.shape[2:]), 1, 0)
    out = lax.map(fn, qb)
    return jnp.moveaxis(out, 0, 1).reshape((b, n) + out.shape[3:])


def heads(t, n_heads, head_dim):
    return t.reshape(t.shape[0], t.shape[1], n_heads, head_dim)


def qkv_proj(h, w_qkv, need_q):
    if need_q:
        q, k, v = jnp.split(h @ w_qkv, 3, axis=-1)
        return q, k, v
    k, v = jnp.split(h @ w_qkv[:, D_MODEL:], 2, axis=-1)
    return None, k, v


def mla_project(h, w_in, g_q, g_kv, w_uq, w_ukv, rope, need_q):
    b, n, _ = h.shape
    if need_q:
        cq, ckv, k_pe = jnp.split(h @ w_in, [A_Q_LORA, A_Q_LORA + A_KV_LORA], axis=-1)
    else:
        ckv, k_pe = jnp.split(h @ w_in[:, A_Q_LORA:], [A_KV_LORA], axis=-1)
    kv = heads(rmsnorm(ckv, g_kv) @ w_ukv, A_HEADS, A_NOPE + A_V)
    k_pe = k_pe[:, :, None, :]
    if rope is not None:
        k_pe = apply_rope(k_pe, *rope)
    k = jnp.concatenate([kv[..., :A_NOPE], jnp.broadcast_to(k_pe, (b, n, A_HEADS, A_ROPE))], axis=-1)
    v = kv[..., A_NOPE:]
    q = None
    if need_q:
        qh = heads(rmsnorm(cq, g_q) @ w_uq, A_HEADS, A_NOPE + A_ROPE)
        q_pe = qh[..., A_NOPE:]
        if rope is not None:
            q_pe = apply_rope(q_pe, *rope)
        q = jnp.concatenate([qh[..., :A_NOPE], q_pe], axis=-1)
    return q, k, v


def mla_mixer(h_lat, h_ctx, w_in, g_q, g_kv, w_uq, w_ukv, w_out, need_ctx_out):
    b, n, _ = h_lat.shape
    scale = (A_NOPE + A_ROPE) ** -0.5
    rope = axial_rope_angles(n, A_ROPE)
    q_l, k_l, v_l = mla_project(h_lat, w_in, g_q, g_kv, w_uq, w_ukv, rope, True)
    q_c, k_c, v_c = mla_project(h_ctx, w_in, g_q, g_kv, w_uq, w_ukv, None, need_ctx_out)
    k_all = jnp.concatenate([k_c, k_l], axis=1)
    v_all = jnp.concatenate([v_c, v_l], axis=1)
    o_l = query_blocks(lambda qb: attend(qb, k_all, v_all, scale), q_l)
    out_lat = o_l.reshape(b, n, A_HEADS * A_V) @ w_out
    out_ctx = None
    if need_ctx_out:
        o_c = attend(q_c, k_c, v_c, scale)
        out_ctx = o_c.reshape(b, h_ctx.shape[1], A_HEADS * A_V) @ w_out
    return out_lat, out_ctx


def diff_heads(h, w_qkv, rope, need_q):
    q, k, v = qkv_proj(h, w_qkv, need_q)
    k = heads(k, 2 * B_HEADS, B_HEAD)
    v = heads(v, B_HEADS, 2 * B_HEAD)
    if q is not None:
        q = heads(q, 2 * B_HEADS, B_HEAD)
    if rope is not None:
        q = apply_rope(q, *rope)
        k = apply_rope(k, *rope)
    return q, k, v


def diff_attend(q, k, v, lam, scale):
    b, nq = q.shape[:2]
    s = jnp.einsum('bqhd,bkhd->bhqk', q, k) * scale
    p = jax.nn.softmax(s.astype(jnp.float32), axis=-1).reshape(b, B_HEADS, 2, nq, k.shape[1])
    a = (p[:, :, 0] - lam * p[:, :, 1]).astype(v.dtype)
    return jnp.einsum('bhqk,bkhd->bqhd', a, v)


def diff_mixer(h_lat, h_ctx, w_qkv, lq1, lk1, lq2, lk2, g_sub, w_out, lambda_init, need_ctx_out):
    b, n, _ = h_lat.shape
    scale = B_HEAD ** -0.5
    rope = axial_rope_angles(n, B_HEAD)
    q_l, k_l, v_l = diff_heads(h_lat, w_qkv, rope, True)
    q_c, k_c, v_c = diff_heads(h_ctx, w_qkv, None, need_ctx_out)
    f = jnp.float32
    lam = (jnp.exp(jnp.sum(lq1.astype(f) * lk1.astype(f)))
           - jnp.exp(jnp.sum(lq2.astype(f) * lk2.astype(f))) + lambda_init)
    k_all = jnp.concatenate([k_c, k_l], axis=1)
    v_all = jnp.concatenate([v_c, v_l], axis=1)

    def finish(o):
        o = rmsnorm(o, g_sub) * (1.0 - lambda_init)
        return o.reshape(o.shape[0], o.shape[1], D_MODEL) @ w_out

    out_lat = finish(query_blocks(lambda qb: diff_attend(qb, k_all, v_all, lam, scale), q_l))
    out_ctx = finish(diff_attend(q_c, k_c, v_c, lam, scale)) if need_ctx_out else None
    return out_lat, out_ctx


def na_mixer(h_lat, h_ctx, w_qkv, rpb, w_out, need_ctx_out):
    b, n, _ = h_lat.shape
    rows = n // GRID_W
    kh, kw = min(C_WIN_H, rows), C_WIN_W
    scale = C_HEAD ** -0.5
    q, k, v = qkv_proj(h_lat, w_qkv, True)
    grid = (b, rows, GRID_W, C_HEADS, C_HEAD)
    q_g, k_g, v_g = q.reshape(grid), k.reshape(grid), v.reshape(grid)
    q_c, k_c, v_c = qkv_proj(h_ctx, w_qkv, need_ctx_out)
    k_c, v_c = heads(k_c, C_HEADS, C_HEAD), heads(v_c, C_HEADS, C_HEAD)

    col = np.arange(GRID_W)
    col_start = np.clip(col - kw // 2, 0, GRID_W - kw)
    col_idx = col_start[:, None] + np.arange(kw)[None, :]
    col_bias_idx = col_idx - col[:, None] + (C_WIN_W - 1)

    def row_step(args):
        r, q_r = args
        rs = jnp.clip(r - kh // 2, 0, rows - kh)
        k_band = lax.dynamic_slice_in_dim(k_g, rs, kh, axis=1)
        v_band = lax.dynamic_slice_in_dim(v_g, rs, kh, axis=1)
        k_nb = k_band[:, :, col_idx]
        v_nb = v_band[:, :, col_idx]
        s_nb = jnp.einsum('bwhd,biwjhd->bhwij', q_r, k_nb) * scale
        row_bias_idx = rs + jnp.arange(kh, dtype=jnp.int32) - r + (C_WIN_H - 1)
        bias = rpb[:, row_bias_idx][:, :, col_bias_idx]
        s_nb = s_nb + jnp.transpose(bias, (0, 2, 1, 3))[None]
        s_ctx = jnp.einsum('bwhd,bkhd->bhwk', q_r, k_c) * scale
        s = jnp.concatenate([s_nb.reshape(b, C_HEADS, GRID_W, kh * kw), s_ctx], axis=-1)
        p = jax.nn.softmax(s.astype(jnp.float32), axis=-1).astype(v_g.dtype)
        p_nb = p[..., :kh * kw].reshape(b, C_HEADS, GRID_W, kh, kw)
        p_ctx = p[..., kh * kw:]
        return (jnp.einsum('bhwij,biwjhd->bwhd', p_nb, v_nb)
                + jnp.einsum('bhwk,bkhd->bwhd', p_ctx, v_c))

    o = lax.map(row_step, (jnp.arange(rows, dtype=jnp.int32), jnp.moveaxis(q_g, 1, 0)))
    out_lat = jnp.moveaxis(o, 0, 1).reshape(b, n, D_MODEL) @ w_out
    out_ctx = None
    if need_ctx_out:
        o_c = attend(heads(q_c, C_HEADS, C_HEAD), k_c, v_c, scale)
        out_ctx = o_c.reshape(b, h_ctx.shape[1], D_MODEL) @ w_out
    return out_lat, out_ctx


def setup_inputs(seed: int = 0) -> dict:
    key = jax.random.key(seed)
    ks = iter(jax.random.split(key, 32))
    f32 = jnp.float32

    def w(shape, fan_in):
        return jax.random.normal(next(ks), shape, f32) * (fan_in ** -0.5)

    def gain(shape):
        return 1.0 + 0.02 * jax.random.normal(next(ks), shape, f32)

    def small(shape, std):
        return std * jax.random.normal(next(ks), shape, f32)

    D = D_MODEL
    return {
        'x': jax.random.normal(next(ks), (BATCH, SEQ, D), f32),
        'c': jax.random.normal(next(ks), (BATCH, D), f32),
        'ctx': jax.random.normal(next(ks), (BATCH, CTX_LEN, D), f32),
        'c_ctx': jax.random.normal(next(ks), (D,), f32),
        'w_mod': w((DEPTH, D, N_MOD * D), D),
        'b_mod': small((DEPTH, N_MOD * D), 0.02),
        'norm_g': gain((DEPTH, 3, D)),
        'w_ffn_gate': w((DEPTH, 2, D, D_FF), D),
        'w_ffn_up': w((DEPTH, 2, D, D_FF), D),
        'w_ffn_down': w((DEPTH, 2, D_FF, D), D_FF),
        'a_w_in': w((N_A_LAYERS, D, A_IN), D),
        'a_q_norm': gain((N_A_LAYERS, A_Q_LORA)),
        'a_kv_norm': gain((N_A_LAYERS, A_KV_LORA)),
        'a_w_uq': w((N_A_LAYERS, A_Q_LORA, A_HEADS * (A_NOPE + A_ROPE)), A_Q_LORA),
        'a_w_ukv': w((N_A_LAYERS, A_KV_LORA, A_HEADS * (A_NOPE + A_V)), A_KV_LORA),
        'a_w_out': w((N_A_LAYERS, A_HEADS * A_V, D), A_HEADS * A_V),
        'b_w_qkv': w((N_B_LAYERS, D, 3 * D), D),
        'b_lambda_q1': small((N_B_LAYERS, B_HEAD), 0.1),
        'b_lambda_k1': small((N_B_LAYERS, B_HEAD), 0.1),
        'b_lambda_q2': small((N_B_LAYERS, B_HEAD), 0.1),
        'b_lambda_k2': small((N_B_LAYERS, B_HEAD), 0.1),
        'b_subln': gain((N_B_LAYERS, 2 * B_HEAD)),
        'b_w_out': w((N_B_LAYERS, D, D), D),
        'c_w_qkv': w((N_C_LAYERS, D, 3 * D), D),
        'c_rpb': small((N_C_LAYERS, C_HEADS, 2 * C_WIN_H - 1, 2 * C_WIN_W - 1), 0.02),
        'c_w_out': w((N_C_LAYERS, D, D), D),
        'final_g': gain((D,)),
    }


def reference(x, c, ctx, c_ctx, w_mod, b_mod, norm_g, w_ffn_gate, w_ffn_up, w_ffn_down,
              a_w_in, a_q_norm, a_kv_norm, a_w_uq, a_w_ukv, a_w_out,
              b_w_qkv, b_lambda_q1, b_lambda_k1, b_lambda_q2, b_lambda_k2, b_subln, b_w_out,
              c_w_qkv, c_rpb, c_w_out, final_g):
    s_lat, s_ctx = x, ctx
    for i in range(DEPTH):
        need_ctx_out = i < DEPTH - 1
        m_lat = modulation(c, w_mod[i], b_mod[i])
        m_ctx = modulation(c_ctx[None, :], w_mod[i], b_mod[i])
        ffn0 = (w_ffn_gate[i, 0], w_ffn_up[i, 0], w_ffn_down[i, 0])
        ffn1 = (w_ffn_gate[i, 1], w_ffn_up[i, 1], w_ffn_down[i, 1])

        s_lat = macaron_half(s_lat, m_lat, 0, norm_g[i, 0], *ffn0)
        s_ctx = macaron_half(s_ctx, m_ctx, 0, norm_g[i, 0], *ffn0)

        h_lat = modulate(s_lat, norm_g[i, 1], m_lat[:, 3], m_lat[:, 4])
        h_ctx = modulate(s_ctx, norm_g[i, 1], m_ctx[:, 3], m_ctx[:, 4])
        kind, j = i % N_MIXERS, i // N_MIXERS
        if kind == 0:
            o_lat, o_ctx = mla_mixer(h_lat, h_ctx, a_w_in[j], a_q_norm[j], a_kv_norm[j],
                                     a_w_uq[j], a_w_ukv[j], a_w_out[j], need_ctx_out)
        elif kind == 1:
            lambda_init = 0.8 - 0.6 * math.exp(-0.3 * i)
            o_lat, o_ctx = diff_mixer(h_lat, h_ctx, b_w_qkv[j], b_lambda_q1[j], b_lambda_k1[j],
                                      b_lambda_q2[j], b_lambda_k2[j], b_subln[j], b_w_out[j],
                                      lambda_init, need_ctx_out)
        else:
            o_lat, o_ctx = na_mixer(h_lat, h_ctx, c_w_qkv[j], c_rpb[j], c_w_out[j], need_ctx_out)

        s_lat = s_lat + m_lat[:, 5, None] * o_lat
        s_lat = macaron_half(s_lat, m_lat, 6, norm_g[i, 2], *ffn1)
        if need_ctx_out:
            s_ctx = s_ctx + m_ctx[:, 5, None] * o_ctx
            s_ctx = macaron_half(s_ctx, m_ctx, 6, norm_g[i, 2], *ffn1)
    return rmsnorm(s_lat, final_g)
```

```cpp
#include <hip/hip_runtime.h>
#include <hip/hip_cooperative_groups.h>
#include <cstdio>
#include <cstdint>
namespace cg = cooperative_groups;

constexpr int DM = 1024, NBATCH = 2, SEQ = 8192, CTXL = 256, TPB = SEQ + CTXL  , MROWS = NBATCH * TPB  ;
constexpr int DFF = 2816, DEPTH = 4, TILES_PB = TPB / 256  ;
constexpr float RMS_EPS = 1e-6f;

constexpr size_t SZ_WGU = 5632ull * 1024 * 2, SZ_WD = 1024ull * 2816 * 2;
constexpr size_t O_WGU = 0;
constexpr size_t O_WD = O_WGU + 8 * SZ_WGU;
constexpr size_t O_AIN = O_WD + 8 * SZ_WD;
constexpr size_t O_AUQ = O_AIN + 2ull * 512 * 1024 * 2;
constexpr size_t O_AUKV = O_AUQ + 2ull * 1536 * 256 * 2;
constexpr size_t O_AOUT = O_AUKV + 2ull * 2048 * 128 * 2;
constexpr size_t O_BQKV = O_AOUT + 2ull * 1024 * 1024 * 2;
constexpr size_t O_BOUT = O_BQKV + 3072ull * 1024 * 2;
constexpr size_t O_CQKV = O_BOUT + 1024ull * 1024 * 2;
constexpr size_t O_COUT = O_CQKV + 3072ull * 1024 * 2;
constexpr size_t O_MOD = O_COUT + 1024ull * 1024 * 2;
constexpr size_t O_ROPE = O_MOD + 4ull * 3 * 9216 * 4;
constexpr size_t O_S = (O_ROPE + 2 * 2048 * 4 + 255) & ~size_t(255);
constexpr size_t O_H = O_S + (size_t)MROWS * 1024 * 4;
constexpr size_t O_X = O_H + (size_t)MROWS * 1024 * 2;
constexpr size_t SZ_M1K = (size_t)MROWS * 1024 * 2;
constexpr size_t XA_CIN = 0, XA_CQN = XA_CIN + (size_t)MROWS * 512 * 4, XA_CKVN = XA_CQN + (size_t)MROWS * 256 * 2, XA_Q = XA_CKVN + (size_t)MROWS * 128 * 2,
                 XA_K = XA_Q + (size_t)MROWS * 1536 * 2, XA_V = XA_K + (size_t)MROWS * 1536 * 2, XA_O = XA_V + SZ_M1K, XA_END = XA_O + SZ_M1K;
constexpr size_t XB_Q = 0, XB_K = SZ_M1K, XB_V = 2 * SZ_M1K, XB_O2 = 3 * SZ_M1K, XB_OUTA = XB_O2 + 2 * SZ_M1K, XB_END = XB_OUTA + SZ_M1K;
constexpr size_t O_P = O_X + (XA_END > XB_END ? XA_END : XB_END);
constexpr size_t O_CTL = O_P + 11ull * 512 * 1024 * 4;
constexpr size_t CTL_BYTES = 16384;
constexpr size_t WS_NEED = O_CTL + CTL_BYTES;

constexpr int LDS_MISC = 157696;
constexpr int LDS_BYTES = LDS_MISC + 1024;
#define LAS __attribute__((address_space(3)))
namespace pg8 {
#define PG8_LAS __attribute__((address_space(3)))
typedef unsigned short bf16_t;
typedef short bf16x8 __attribute__((ext_vector_type(8)));
typedef float f32x4 __attribute__((ext_vector_type(4)));
typedef unsigned u32x4 __attribute__((ext_vector_type(4)));
constexpr int BM = 256, BK = 64, HALF = 128, HTB = HALF * BK * 2  , STAGE_BYTES = 8 * HTB, NXCD = 8, WGM = 8;

__host__ __device__ __forceinline__ int lds_byte(int r, int c) { const int st = (r >> 4) * 2 + (c >> 5), rr = r & 15, cc = c & 31, ob = rr * 64 + cc * 2; return st * 1024 + (ob ^ (((ob >> 9) & 1) << 5)); }
__host__ __device__ __forceinline__ void stage_rc(int b, int& R, int& C) { const int st = b / 1024, sb = b % 1024, swz = sb ^ (((sb >> 9) & 1) << 5); R = (st >> 1) * 16 + swz / 64; C = (st & 1) * 32 + (swz % 64) / 2; }
__host__ __device__ __forceinline__ int perm32(int rho) { const int n = rho >> 4, i = rho & 15; return 8 * (i >> 2) + 4 * n + (i & 3); }

struct Unit { int pm, pn, k0, nk, flags; };
struct Gemm { const bf16_t* A; const bf16_t* Bt; int M, N, K; };

struct StaticOrder {
    int nM, nN, nwg, G, c, ntk;
    __host__ __device__ void init(int M, int N, int K, int G_, int c_) { nM = M / BM; nN = N / BM; nwg = nM * nN; G = G_; c = c_; ntk = K / BK; }
    __host__ __device__ bool next(int i, Unit& u) const {
        const long L = (long)i * G + c; if (L >= nwg) return false;
        int wgid = (int)L; { const int q = nwg / NXCD, r = nwg % NXCD, xcd = wgid % NXCD, off = wgid / NXCD; wgid = (xcd < r ? xcd * (q + 1) : r * (q + 1) + (xcd - r) * q) + off; }
        const int nig = WGM * nN, gid = wgid / nig, fm = gid * WGM, gsz = (nM - fm) < WGM ? (nM - fm) : WGM;
        u.pm = fm + ((wgid % nig) % gsz); u.pn = (wgid % nig) / gsz; u.k0 = 0; u.nk = ntk; u.flags = 0; return true;
    }
    __device__ __forceinline__ void a_ready(const Unit&) const {}
    __device__ __forceinline__ void done(const Unit&) const {}
};
struct SplitOrder {
    StaticOrder so; int nN, ntk, nsp, nfull, nsu, G, c; bool split;
    __device__ void init(int N, int K, int G_, int c_, bool split_, bool ctx_units) {
        split = split_; G = G_; c = c_; nN = N / BM; ntk = K / BK; nsp = ntk / 4;
        if (split) { so.init(64 * BM, N, K, G_, c_); nfull = 64 * nN; nsu = ctx_units ? 2 * nN * nsp : 0; } else { so.init(66 * BM, N, K, G_, c_); nfull = 66 * nN; nsu = 0; }
    }
    __device__ bool next(int i, Unit& u) const {
        const long L = (long)i * G + c;
        if (L < nfull) { so.next(i, u); if (split) u.pm = u.pm < 32 ? u.pm + 1 : u.pm + 2; return true; }
        const int s = (int)(L - nfull); if (s >= nsu) return false;
        const int per = nN * nsp, cb = s / per, r = s - cb * per;
        u.pm = cb * 33; u.pn = r / nsp; u.k0 = 4 * (r - u.pn * nsp); u.nk = 4; u.flags = 1; return true;
    }
    __device__ __forceinline__ void a_ready(const Unit&) const {}
    __device__ __forceinline__ void done(const Unit&) const {}
};
__device__ __forceinline__ unsigned cvt_pk_bf16(float lo, float hi) { unsigned r; asm volatile("v_cvt_pk_bf16_f32 %0, %1, %2" : "=v"(r) : "v"(lo), "v"(hi)); return r; }
__device__ __forceinline__ u32x4 pack8(const f32x4 a, const f32x4 b) { u32x4 w; w.x = cvt_pk_bf16(a[0], a[1]); w.y = cvt_pk_bf16(a[2], a[3]); w.z = cvt_pk_bf16(b[0], b[1]); w.w = cvt_pk_bf16(b[2], b[3]); return w; }
typedef unsigned u32x2e __attribute__((ext_vector_type(2)));
__device__ __forceinline__ u32x2e pack8_fp8(const f32x4 a, const f32x4 b) {
    int w0 = __builtin_amdgcn_cvt_pk_fp8_f32(a[0], a[1], 0, false); w0 = __builtin_amdgcn_cvt_pk_fp8_f32(a[2], a[3], w0, true);
    int w1 = __builtin_amdgcn_cvt_pk_fp8_f32(b[0], b[1], 0, false); w1 = __builtin_amdgcn_cvt_pk_fp8_f32(b[2], b[3], w1, true);
    u32x2e r; r.x = (unsigned)w0; r.y = (unsigned)w1; return r;
}
__device__ __forceinline__ float silu_f(float g) { return g * __builtin_amdgcn_rcpf(1.0f + __builtin_amdgcn_exp2f(-1.4426950408889634f * g)); }

struct EpiB {
    static constexpr bool PERM = true, AFTER_DRAIN = false;
    int mode; unsigned char* ws;
    __device__ __forceinline__ void operator()(const f32x4 (&acc)[2][2][4][2], const Unit& u, int wr, int wc, int fr, int fq) const {
        const int row0 = u.pm * BM + wr * 64 + fr;
        const int o8 = wc * 32 + 8 * fq;
        unsigned char* const X = ws + O_X;
        bf16_t* const o0 = (bf16_t*)(X + (mode == 3 ? XA_K : (mode == 4 ? XA_Q : 0)));
        bf16_t* const o1 = (bf16_t*)(X + (mode == 3 ? XA_V : XB_K));
        bf16_t* const o2 = (bf16_t*)(X + XB_V);
        const float* const rope = (const float*)(ws + O_ROPE);
        if (mode == 0) {
#pragma unroll
            for (int ai = 0; ai < 2; ++ai)
#pragma unroll
                for (int m = 0; m < 4; ++m) {
                    const size_t r = (size_t)(row0 + ai * HALF + m * 16);
                    f32x4 v0, v1;
#pragma unroll
                    for (int i = 0; i < 4; ++i) { v0[i] = silu_f(acc[ai][0][m][0][i]) * acc[ai][1][m][0][i]; v1[i] = silu_f(acc[ai][0][m][1][i]) * acc[ai][1][m][1][i]; }
                    *(u32x4*)(o0 + r * 2816 + u.pn * 128 + o8) = pack8(v0, v1);
                    if (m & 1) asm volatile("" ::: "memory");
                }
            return;
        }
        const bool ropet = (mode == 2 && u.pn < 8) || (mode == 4 && u.pn >= 4);
        if (!ropet) {
#pragma unroll
            for (int bj = 0; bj < 2; ++bj) {
                bf16_t* base; size_t ld; int col;
                if ((mode == 3 && bj == 0) || mode == 4) {
                    unsigned char* b8 = (unsigned char*)o0; const int colb = (mode == 3) ? (u.pn * 192 + o8) : ((2 * u.pn + bj) * 192 + o8);
#pragma unroll
                    for (int ai = 0; ai < 2; ++ai)
#pragma unroll
                        for (int m = 0; m < 4; ++m) {
                            const size_t r = (size_t)(row0 + ai * HALF + m * 16);
                            *(u32x2e*)(b8 + r * 1536 + colb) = pack8_fp8(acc[ai][bj][m][0], acc[ai][bj][m][1]);
                        }
                    continue;
                }
                if (mode == 3) {
                    unsigned char* v8 = (unsigned char*)o1; const int bb3 = u.pm / 33;
#pragma unroll
                    for (int ai = 0; ai < 2; ++ai)
#pragma unroll
                        for (int m = 0; m < 4; ++m) {
                            const int key = row0 + ai * HALF + m * 16 - bb3 * TPB;
                            const int k6 = key & 63, kp = 32 * ((k6 >> 2) & 1) + 4 * (k6 >> 3) + (k6 & 3);
                            unsigned char* tp = v8 + ((size_t)((bb3 * 8 + u.pn) * 132 + (key >> 6)) * 8192) + (size_t)o8 * 64 + kp;
                            const u32x2e w = pack8_fp8(acc[ai][1][m][0], acc[ai][1][m][1]);
#pragma unroll
                            for (int e = 0; e < 4; ++e) { tp[e * 64] = (unsigned char)(w.x >> (8 * e)); tp[(4 + e) * 64] = (unsigned char)(w.y >> (8 * e)); }
                        }
                    continue;
                }
                else { const int gcol = u.pn * 256 + bj * 128 + o8; const int buf = gcol >> 10; base = buf == 0 ? o0 : (buf == 1 ? o1 : o2); ld = 1024; col = gcol & 1023; }
#pragma unroll
                for (int ai = 0; ai < 2; ++ai)
#pragma unroll
                    for (int m = 0; m < 4; ++m) {
                        const size_t r = (size_t)(row0 + ai * HALF + m * 16);
                        *(u32x4*)(base + r * ld + col) = pack8(acc[ai][bj][m][0], acc[ai][bj][m][1]);
                    }
            }
            return;
        }
        {
            bf16_t* base; size_t ld; int col1;
            if (mode == 2) { base = (u.pn < 4) ? o0 : o1; ld = 1024; col1 = (u.pn & 3) * 256 + 64 * wc + 8 * fq; }
            else { base = o0; ld = 1536; col1 = (4 * (u.pn - 4) + wc) * 192 + 128 + 8 * fq; }
            const int bb = u.pm / 33; const bool lat = (u.pm - bb * 33) != 0;
#pragma unroll
            for (int ai = 0; ai < 2; ++ai)
#pragma unroll
                for (int m = 0; m < 4; ++m) {
                    const int ri = row0 + ai * HALF + m * 16; const size_t r = (size_t)ri;
                    f32x4 y1a = acc[ai][0][m][0], y1b = acc[ai][0][m][1], y2a = acc[ai][1][m][0], y2b = acc[ai][1][m][1];
                    if (lat) {
                        const int t = ri - bb * TPB - CTXL; const int pos = (fq < 2) ? (t >> 6) : (t & 63);
                        const float* cp = rope + pos * 16 + 8 * (fq & 1);
                        const f32x4 c0 = *(const f32x4*)cp, c1 = *(const f32x4*)(cp + 4), s0 = *(const f32x4*)(cp + 2048), s1 = *(const f32x4*)(cp + 2052);
                        const f32x4 x1a = y1a, x1b = y1b, x2a = y2a, x2b = y2b;
                        y1a = x1a * c0 - x2a * s0; y1b = x1b * c1 - x2b * s1;
                        y2a = x1a * s0 + x2a * c0; y2b = x1b * s1 + x2b * c1;
                    }
                    if (mode == 4) { unsigned char* b8 = (unsigned char*)o0;
                        *(u32x2e*)(b8 + r * 1536 + col1) = pack8_fp8(y1a, y1b); *(u32x2e*)(b8 + r * 1536 + col1 + 32) = pack8_fp8(y2a, y2b); }
                    else { *(u32x4*)(base + r * ld + col1) = pack8(y1a, y1b);
                    *(u32x4*)(base + r * ld + col1 + 32) = pack8(y2a, y2b); }
                    asm volatile("" ::: "memory");
                }
        }
    }
};

struct EpiF {
    static constexpr bool PERM = false, AFTER_DRAIN = false;
    int mode; unsigned char* ws; int modoff;
    __device__ __forceinline__ void operator()(const f32x4 (&acc)[2][2][4][2], const Unit& u, int wr, int wc, int fr, int fq) const {
        float* const out = (float*)(ws + (mode == 1 ? (O_X + XA_CIN) : O_S)); const int ld = 512;
        const float* const modg = (const float*)(ws + O_MOD) + modoff; const float coef = mode == 0 ? 0.5f : 1.0f;
        const int row0 = u.pm * BM + wr * 64 + fr; const int col0 = u.pn * BM + wc * 32 + 4 * fq;
        if (u.flags & 1) {
            float* P = (float*)(ws + O_P) + ((size_t)(u.k0 >> 2) * 512 + (u.pm ? 256 : 0) + wr * 64 + fr) * 1024 + col0;
#pragma unroll
            for (int ai = 0; ai < 2; ++ai)
#pragma unroll
                for (int m = 0; m < 4; ++m) {
                    float* rp = P + (size_t)(ai * HALF + m * 16) * 1024;
#pragma unroll
                    for (int bj = 0; bj < 2; ++bj)
#pragma unroll
                        for (int n = 0; n < 2; ++n) *(f32x4*)(rp + bj * HALF + n * 16) = acc[ai][bj][m][n];
                }
            return;
        }
        if (mode != 1) {
            const int bb = u.pm / 33; const int mi = ((u.pm - bb * 33) == 0) ? 2 : bb;
            f32x4 gv[2][2];
#pragma unroll
            for (int bj = 0; bj < 2; ++bj)
#pragma unroll
                for (int n = 0; n < 2; ++n) gv[bj][n] = *(const f32x4*)(modg + mi * 9216 + col0 + bj * HALF + n * 16) * coef;
#pragma unroll
            for (int ai = 0; ai < 2; ++ai)
#pragma unroll
                for (int m = 0; m < 4; ++m) {
                    float* rp = out + (size_t)(row0 + ai * HALF + m * 16) * 1024 + col0;
#pragma unroll
                    for (int bj = 0; bj < 2; ++bj)
#pragma unroll
                        for (int n = 0; n < 2; ++n) { f32x4* p = (f32x4*)(rp + bj * HALF + n * 16); *p = *p + gv[bj][n] * acc[ai][bj][m][n]; }
                    asm volatile("" ::: "memory");
                }
        } else {
#pragma unroll
            for (int ai = 0; ai < 2; ++ai)
#pragma unroll
                for (int m = 0; m < 4; ++m) {
                    float* rp = out + (size_t)(row0 + ai * HALF + m * 16) * ld + col0;
#pragma unroll
                    for (int bj = 0; bj < 2; ++bj)
#pragma unroll
                        for (int n = 0; n < 2; ++n) *(f32x4*)(rp + bj * HALF + n * 16) = acc[ai][bj][m][n];
                }
        }
    }
};

template <class Epi, class Sched, bool ALIGN_EPI = false, bool SP2 = false>
__device__ __forceinline__ void gemm_phase(PG8_LAS unsigned char* lds, const Gemm g, const Sched& S, const Epi& E) {
    int tid_ = threadIdx.x; asm volatile("" : "+v"(tid_));
    const int tid = tid_, wid = __builtin_amdgcn_readfirstlane(tid >> 6), lane = tid & 63, wr = wid >> 2, wc = wid & 3, fr = lane & 15, fq = lane >> 4;
    const int K = g.K;
    unsigned voffA[2], voffB[2];
#pragma unroll
    for (int i = 0; i < 2; ++i) { int R, C; stage_rc(tid * 16 + i * 8192, R, C); const int Rb = Epi::PERM ? ((R & ~31) + perm32(R & 31)) : R;
        voffA[i] = (unsigned)(R * K + C) * 2u; voffB[i] = (unsigned)(Rb * K + C) * 2u; }
    const size_t kstep = (size_t)(BK * 2);
    const size_t hstep = (size_t)HALF * K * 2;
    const size_t tstep = 2 * hstep;
    const unsigned ldsw = (unsigned)wid * 1024u;
    const int aoff = lds_byte(wr * 64 + fr, fq * 8), boff = lds_byte(wc * 32 + fr, fq * 8);
#define PG8_SA(b, h) (((b) * 2 + (h)) * HTB)
#define PG8_SB(b, h) ((4 + (b) * 2 + (h)) * HTB)
#define PG8_STAGE(bufoff, gbase, voff) do { _Pragma("unroll") for (int _i = 0; _i < 2; ++_i) \
        __builtin_amdgcn_global_load_lds((const unsigned*)((const char*)(gbase) + (voff)[_i]), (PG8_LAS unsigned*)(lds + (bufoff) + ldsw + _i * 8192), 16, 0, 0); } while (0)
#define PG8_LDA(dst, b, h) do { _Pragma("unroll") for (int m = 0; m < 4; ++m) _Pragma("unroll") for (int k = 0; k < 2; ++k) dst[m][k] = *(const PG8_LAS bf16x8*)(lds + PG8_SA(b, h) + aoff + m * 2048 + k * 1024); } while (0)
#define PG8_LDB(dst, b, h) do { _Pragma("unroll") for (int n = 0; n < 2; ++n) _Pragma("unroll") for (int k = 0; k < 2; ++k) dst[n][k] = *(const PG8_LAS bf16x8*)(lds + PG8_SB(b, h) + boff + n * 2048 + k * 1024); } while (0)
#define PG8_MMA(ai, bj, At, Bt) do { __builtin_amdgcn_s_setprio(1); _Pragma("unroll") for (int m = 0; m < 4; ++m) _Pragma("unroll") for (int n = 0; n < 2; ++n) _Pragma("unroll") for (int k = 0; k < 2; ++k) \
        acc[ai][bj][m][n] = __builtin_amdgcn_mfma_f32_16x16x32_bf16(Bt[n][k], At[m][k], acc[ai][bj][m][n], 0, 0, 0); __builtin_amdgcn_s_setprio(0); } while (0)
#define PG8_WAIT_V(n) asm volatile("s_waitcnt vmcnt(" #n ")" ::: "memory")
#define PG8_WAIT_L(n) asm volatile("s_waitcnt lgkmcnt(" #n ")" ::: "memory")
#define PG8_BAR __builtin_amdgcn_s_barrier()
#define PG8_SCHED __builtin_amdgcn_sched_barrier(0)
    Unit cur, nxt; int ui = 0;
    if (!S.next(0, cur)) return;
    f32x4 acc[2][2][4][2];
#pragma unroll
    for (int a = 0; a < 2; ++a)
#pragma unroll
        for (int b = 0; b < 2; ++b)
#pragma unroll
            for (int m = 0; m < 4; ++m)
#pragma unroll
                for (int n = 0; n < 2; ++n) acc[a][b][m][n] = (f32x4){0.f, 0.f, 0.f, 0.f};
    bf16x8 At[4][2], B0[2][2], B1[2][2];
    const char* cA = (const char*)g.A + (size_t)cur.pm * tstep + (size_t)cur.k0 * kstep; const char* cB = (const char*)g.Bt + (size_t)cur.pn * tstep + (size_t)cur.k0 * kstep; int nt = cur.nk;
    S.a_ready(cur);
    if constexpr (SP2) {
        PG8_STAGE(PG8_SB(0, 0), cB, voffB); PG8_STAGE(PG8_SB(0, 1), cB + hstep, voffB); PG8_STAGE(PG8_SA(0, 0), cA, voffA); PG8_STAGE(PG8_SA(0, 1), cA + hstep, voffA);
        if (wr == 1) PG8_BAR;
        PG8_WAIT_V(2); PG8_BAR;
        PG8_STAGE(PG8_SB(1, 0), cB + kstep, voffB); PG8_STAGE(PG8_SA(1, 0), cA + kstep, voffA); PG8_STAGE(PG8_SB(1, 1), cB + hstep + kstep, voffB);
        PG8_WAIT_V(6); PG8_BAR;
    } else {
        PG8_STAGE(PG8_SB(0, 0), cB, voffB); PG8_STAGE(PG8_SA(0, 0), cA, voffA); PG8_STAGE(PG8_SB(0, 1), cB + hstep, voffB); PG8_STAGE(PG8_SA(0, 1), cA + hstep, voffA);
        if (wr == 1) PG8_BAR;
        PG8_WAIT_V(4); PG8_BAR;
        PG8_STAGE(PG8_SB(1, 0), cB + kstep, voffB); PG8_STAGE(PG8_SA(1, 0), cA + kstep, voffA); PG8_STAGE(PG8_SB(1, 1), cB + hstep + kstep, voffB);
        PG8_WAIT_V(6); PG8_BAR;
    }
    for (;;) {
        const bool has_next = S.next(ui + 1, nxt);
        const char* nA = has_next ? (const char*)g.A + (size_t)nxt.pm * tstep + (size_t)nxt.k0 * kstep : cA; const char* nB = has_next ? (const char*)g.Bt + (size_t)nxt.pn * tstep + (size_t)nxt.k0 * kstep : cB;
        for (int t = 0; t < nt; t += 2) {
            const bool last = (t == nt - 2);
            const char* a1 = cA + (size_t)(t + 1) * kstep;
            const char* a2 = last ? nA : cA + (size_t)(t + 2) * kstep; const char* b2 = last ? nB : cB + (size_t)(t + 2) * kstep;
            const char* a3 = a2 + kstep; const char* b3 = b2 + kstep;
            if (last && has_next) S.a_ready(nxt);
            if constexpr (SP2) {
            PG8_LDB(B0, 0, 0); PG8_LDB(B1, 0, 1); PG8_SCHED; PG8_LDA(At, 0, 0); PG8_STAGE(PG8_SA(1, 1), a1 + hstep, voffA);
            PG8_WAIT_V(8); PG8_WAIT_L(0); PG8_BAR; PG8_MMA(0, 0, At, B0); PG8_MMA(0, 1, At, B1); PG8_BAR; PG8_SCHED;
            PG8_LDA(At, 0, 1); PG8_STAGE(PG8_SB(0, 0), b2, voffB); PG8_STAGE(PG8_SB(0, 1), b2 + hstep, voffB); PG8_STAGE(PG8_SA(0, 0), a2, voffA);
            PG8_WAIT_V(8); PG8_WAIT_L(0); PG8_BAR; PG8_MMA(1, 0, At, B0); PG8_MMA(1, 1, At, B1); PG8_BAR; PG8_SCHED;
            PG8_LDB(B0, 1, 0); PG8_LDB(B1, 1, 1); PG8_SCHED; PG8_LDA(At, 1, 0); PG8_STAGE(PG8_SA(0, 1), a2 + hstep, voffA);
            PG8_WAIT_V(8); PG8_WAIT_L(0); PG8_BAR; PG8_MMA(0, 0, At, B0); PG8_MMA(0, 1, At, B1); PG8_BAR; PG8_SCHED;
            PG8_LDA(At, 1, 1); PG8_STAGE(PG8_SB(1, 0), b3, voffB); PG8_STAGE(PG8_SB(1, 1), b3 + hstep, voffB); PG8_STAGE(PG8_SA(1, 0), a3, voffA);
            PG8_WAIT_V(8); PG8_WAIT_L(0); PG8_BAR; PG8_MMA(1, 0, At, B0); PG8_MMA(1, 1, At, B1); PG8_BAR; PG8_SCHED;
            } else {
            PG8_LDB(B0, 0, 0); PG8_SCHED; PG8_LDA(At, 0, 0); PG8_STAGE(PG8_SA(1, 1), a1 + hstep, voffA);
            PG8_WAIT_L(8); PG8_BAR; PG8_WAIT_L(0); PG8_MMA(0, 0, At, B0); PG8_BAR; PG8_SCHED;
            PG8_LDB(B1, 0, 1); PG8_STAGE(PG8_SB(0, 0), b2, voffB);
            PG8_BAR; PG8_WAIT_L(0); PG8_MMA(0, 1, At, B1); PG8_BAR;
            PG8_LDA(At, 0, 1); PG8_STAGE(PG8_SA(0, 0), a2, voffA);
            PG8_BAR; PG8_WAIT_L(0); PG8_MMA(1, 0, At, B0); PG8_BAR; PG8_SCHED;
            PG8_STAGE(PG8_SB(0, 1), b2 + hstep, voffB);
            PG8_WAIT_V(6); PG8_BAR; PG8_MMA(1, 1, At, B1); PG8_BAR;
            PG8_LDB(B0, 1, 0); PG8_SCHED; PG8_LDA(At, 1, 0); PG8_STAGE(PG8_SA(0, 1), a2 + hstep, voffA);
            PG8_WAIT_L(8); PG8_BAR; PG8_WAIT_L(0); PG8_MMA(0, 0, At, B0); PG8_BAR; PG8_SCHED;
            PG8_LDB(B1, 1, 1); PG8_STAGE(PG8_SB(1, 0), b3, voffB);
            PG8_BAR; PG8_WAIT_L(0); PG8_MMA(0, 1, At, B1); PG8_BAR;
            PG8_LDA(At, 1, 1); PG8_STAGE(PG8_SA(1, 0), a3, voffA);
            PG8_BAR; PG8_WAIT_L(0); PG8_MMA(1, 0, At, B0); PG8_BAR; PG8_SCHED;
            PG8_STAGE(PG8_SB(1, 1), b3 + hstep, voffB);
            PG8_WAIT_V(6); PG8_BAR; PG8_MMA(1, 1, At, B1); PG8_BAR;
            }
        }
        if constexpr (ALIGN_EPI) { if (wr == 0) PG8_BAR; }
        if constexpr (!Epi::AFTER_DRAIN) { E(acc, cur, wr, wc, fr, fq); S.done(cur); }
        if (!has_next) break;
#pragma unroll
        for (int a = 0; a < 2; ++a)
#pragma unroll
            for (int b = 0; b < 2; ++b)
#pragma unroll
                for (int m = 0; m < 4; ++m)
#pragma unroll
                    for (int n = 0; n < 2; ++n) acc[a][b][m][n] = (f32x4){0.f, 0.f, 0.f, 0.f};
        cur = nxt; cA = nA; cB = nB; ++ui; nt = cur.nk;
        if constexpr (ALIGN_EPI) { if (wr == 1) PG8_BAR; }
    }
    PG8_WAIT_V(0);
    if constexpr (!ALIGN_EPI) { if (wr == 0) PG8_BAR; }
    PG8_BAR;
    if constexpr (Epi::AFTER_DRAIN) { E.fused(acc, cur, wr, wc, fr, fq, lds, wid, lane); S.done(cur); }
#undef PG8_SA
#undef PG8_SB
#undef PG8_STAGE
#undef PG8_LDA
#undef PG8_LDB
#undef PG8_MMA
#undef PG8_WAIT_V
#undef PG8_WAIT_L
#undef PG8_BAR
#undef PG8_SCHED
}
}
namespace att {
typedef unsigned short bf16_t;
using bf16x8 = __attribute__((ext_vector_type(8))) short;
using s16x4  = __attribute__((ext_vector_type(4))) short;
using f32x16 = __attribute__((ext_vector_type(16))) float;
using u32x4  = __attribute__((ext_vector_type(4))) unsigned;
#define SBAR() __builtin_amdgcn_sched_barrier(0)
__device__ __forceinline__ int crow(int r, int hi) { return (r & 3) + 8 * (r >> 2) + 4 * hi; }
__device__ __forceinline__ unsigned cvtpk(float lo, float hi) { unsigned r; asm volatile("v_cvt_pk_bf16_f32 %0, %1, %2" : "=v"(r) : "v"(lo), "v"(hi)); return r; }
constexpr float THRN = 8.f;

typedef float f32x2v __attribute__((ext_vector_type(2)));
__device__ __forceinline__ void partialSM(f32x16& p0, f32x16& p1, float& m_reg, float& mn, float& alpha, const float C, const float thrS) {
  float pmax = p0[0];
#pragma unroll
  for (int r = 1; r < 16; ++r) pmax = fmaxf(pmax, p0[r]);
#pragma unroll
  for (int r = 0; r < 16; ++r) pmax = fmaxf(pmax, p1[r]);
  { auto rr = __builtin_amdgcn_permlane32_swap(__float_as_uint(pmax), __float_as_uint(pmax), false, false);
    pmax = fmaxf(__uint_as_float(rr[0]), __uint_as_float(rr[1])); }
  if (__builtin_expect(__all(pmax - m_reg <= thrS), 1)) { mn = m_reg; alpha = 1.f; }
  else { mn = fmaxf(m_reg, pmax); alpha = __builtin_amdgcn_exp2f((m_reg - mn) * C); m_reg = mn; }
  const float mnC = -mn * C;
#pragma unroll
  for (int r = 0; r < 16; ++r) p0[r] = fmaf(p0[r], C, mnC);
#pragma unroll
  for (int r = 0; r < 16; ++r) p1[r] = fmaf(p1[r], C, mnC);
#pragma unroll
  for (int r = 0; r < 16; ++r) p0[r] = __builtin_amdgcn_exp2f(p0[r]);
}
__device__ __forceinline__ void finishSM(f32x16& p0, f32x16& p1, float alpha, float& l_reg, bf16x8& pa0, bf16x8& pa1, bf16x8& pa2, bf16x8& pa3) {
#pragma unroll
  for (int r = 0; r < 16; ++r) p1[r] = __builtin_amdgcn_exp2f(p1[r]);
  float ps = 0;
#pragma unroll
  for (int r = 0; r < 16; ++r) ps += p0[r];
#pragma unroll
  for (int r = 0; r < 16; ++r) ps += p1[r];
  { auto rr = __builtin_amdgcn_permlane32_swap(__float_as_uint(ps), __float_as_uint(ps), false, false);
    ps = __uint_as_float(rr[0]) + __uint_as_float(rr[1]); }
  l_reg = l_reg * alpha + ps;
#define PK4(P, BASE, OUT) do { unsigned a0 = cvtpk(P[BASE + 0], P[BASE + 1]), a1 = cvtpk(P[BASE + 2], P[BASE + 3]);   \
    unsigned b0 = cvtpk(P[BASE + 4], P[BASE + 5]), b1 = cvtpk(P[BASE + 6], P[BASE + 7]);                              \
    auto r0 = __builtin_amdgcn_permlane32_swap(a0, b0, false, false); auto r1 = __builtin_amdgcn_permlane32_swap(a1, b1, false, false); \
    u32x4 w = {r0[0], r1[0], r0[1], r1[1]}; OUT = *reinterpret_cast<bf16x8*>(&w); } while (0)
  PK4(p0, 0, pa0); PK4(p0, 8, pa1); PK4(p1, 0, pa2); PK4(p1, 8, pa3);
#undef PK4
}
template <int DQK>
__device__ __forceinline__ int kswz(int row, int colB) { return row * (DQK * 2) + (colB ^ ((row & 7) << 4)); }
template <int DQK, int NQR>
__device__ __forceinline__ void qkt(f32x16& p0, f32x16& p1, const char* Ks, const bf16x8* qr, const char* qls, int r32, int hi) {
  constexpr int N = DQK / 16;
  const char* k0p = Ks + (r32 ^ ((r32 >> 4) & 1)) * (DQK * 2); const char* k1p = k0p + 32 * (DQK * 2); const int swz = (r32 & 7) << 4;
  p0 = f32x16{}; p1 = f32x16{};
  bf16x8 c0 = *reinterpret_cast<const bf16x8*>(k0p + ((hi * 16) ^ swz)), c1 = *reinterpret_cast<const bf16x8*>(k1p + ((hi * 16) ^ swz));
  bf16x8 cq = c0; if (NQR == 0) cq = *reinterpret_cast<const bf16x8*>(qls);
#pragma unroll
  for (int d0 = 0; d0 < N; ++d0) {
    bf16x8 n0 = c0, n1 = c1, nq = cq;
    if (d0 + 1 < N) { const int cb = ((d0 + 1) * 32 + hi * 16) ^ swz;
      n0 = *reinterpret_cast<const bf16x8*>(k0p + cb); n1 = *reinterpret_cast<const bf16x8*>(k1p + cb);
      if (d0 + 1 >= NQR) nq = *reinterpret_cast<const bf16x8*>(qls + (d0 + 1 - NQR) * 1024); }
    SBAR();
    const bf16x8 qf = (d0 < NQR) ? qr[d0 < NQR ? d0 : 0] : cq;
    p0 = __builtin_amdgcn_mfma_f32_32x32x16_bf16(c0, qf, p0, 0, 0, 0);
    p1 = __builtin_amdgcn_mfma_f32_32x32x16_bf16(c1, qf, p1, 0, 0, 0);
    SBAR();
    c0 = n0; c1 = n1; cq = nq;
  }
}
template <int DV>
__device__ __forceinline__ int v_st(int k, int c) { const int kk = (k & ~0xC) | ((k & 4) << 1) | ((k & 8) >> 1); return ((kk >> 3) * (DV / 32) + (c >> 5)) * 512 + ((kk & 7) * 32 + (c & 31)) * 2; }
__device__ __forceinline__ int v_rd_base(int lane) { return ((lane & 3) << 3) | (((lane >> 2) & 3) << 6) | (((lane >> 4) & 1) << 5) | (((lane >> 5) & 1) << 8); }
template <int DV> constexpr int v_rd_off(int d0, int ks, int half) { return d0 * 512 + ks * (2 * (DV / 32) * 512) + half * ((DV / 32) * 512); }
template <int OFF> __device__ __forceinline__ s16x4 tr_read(int vb) {
  s16x4 r; asm volatile("ds_read_b64_tr_b16 %0, %1 offset:%2" : "=&v"(r) : "v"(vb), "i"(OFF) : "memory"); return r;
}
template <int OFF> __device__ __forceinline__ bf16x8 lds_read128(int addr) {
  bf16x8 r; asm volatile("ds_read_b128 %0, %1 offset:%2" : "=&v"(r) : "v"(addr), "i"(OFF) : "memory"); return r;
}
template <int N> __device__ __forceinline__ void lgkm_wait() {
  if constexpr (N <= 0) asm volatile("s_waitcnt lgkmcnt(0)" ::: "memory");
  else if constexpr (N == 1) asm volatile("s_waitcnt lgkmcnt(1)" ::: "memory");
  else if constexpr (N == 2) asm volatile("s_waitcnt lgkmcnt(2)" ::: "memory");
  else if constexpr (N == 3) asm volatile("s_waitcnt lgkmcnt(3)" ::: "memory");
  else if constexpr (N == 4) asm volatile("s_waitcnt lgkmcnt(4)" ::: "memory");
  else if constexpr (N == 5) asm volatile("s_waitcnt lgkmcnt(5)" ::: "memory");
  else if constexpr (N == 6) asm volatile("s_waitcnt lgkmcnt(6)" ::: "memory");
  else if constexpr (N == 7) asm volatile("s_waitcnt lgkmcnt(7)" ::: "memory");
  else if constexpr (N == 8) asm volatile("s_waitcnt lgkmcnt(8)" ::: "memory");
  else asm volatile("s_waitcnt lgkmcnt(9)" ::: "memory");
}
template <int DV, int I> __device__ __forceinline__ void pv_issue(int vb, s16x4& l, s16x4& h) {
  constexpr int ND0 = DV / 32, ks = I / ND0, d0 = I % ND0;
  l = tr_read<v_rd_off<DV>(d0, ks, 0)>(vb); h = tr_read<v_rd_off<DV>(d0, ks, 1)>(vb);
}
template <int DV, int I> __device__ __forceinline__ void pv_step(f32x16* o, int vb, const bf16x8 (&pa)[4], s16x4 (&L)[4], s16x4 (&H)[4]) {
  constexpr int ND0 = DV / 32, NM = 4 * ND0, ks = I / ND0, d0 = I % ND0;
  if constexpr (I + 3 < NM) pv_issue<DV, I + 3>(vb, L[(I + 3) & 3], H[(I + 3) & 3]);
  constexpr int ahead = (NM - 1 - I) < 3 ? (NM - 1 - I) : 3;
  lgkm_wait<2 * ahead>(); SBAR();
  const s16x4 l = L[I & 3], h = H[I & 3];
  o[d0] = __builtin_amdgcn_mfma_f32_32x32x16_bf16(pa[ks], (bf16x8){l[0], l[1], l[2], l[3], h[0], h[1], h[2], h[3]}, o[d0], 0, 0, 0);
  SBAR();
  if constexpr (I + 1 < NM) pv_step<DV, I + 1>(o, vb, pa, L, H);
}
template <int DV> __device__ __forceinline__ void pv_pipe(f32x16* o, int vb, bf16x8 pa0, bf16x8 pa1, bf16x8 pa2, bf16x8 pa3) {
  const bf16x8 pa[4] = {pa0, pa1, pa2, pa3}; s16x4 L[4], H[4];
  SBAR();
  pv_issue<DV, 0>(vb, L[0], H[0]); pv_issue<DV, 1>(vb, L[1], H[1]); pv_issue<DV, 2>(vb, L[2], H[2]);
  pv_step<DV, 0>(o, vb, pa, L, H);
}
template <int DQK, int NQR, int D> __device__ __forceinline__ void qk_issue(const int (&ka)[4], int qaddr, bf16x8& b0, bf16x8& b1, bf16x8& q) {
  constexpr int off = (D >> 2) * 128;
  b0 = lds_read128<off>(ka[D & 3]); b1 = lds_read128<off + 32 * DQK * 2>(ka[D & 3]);
  if constexpr (D >= NQR) q = lds_read128<(D - NQR) * 1024>(qaddr);
}
template <int DQK, int NQR, int A> constexpr int qk_reads_after(int d) {
  int n = 0; for (int e = d + 1; e <= d + A && e < DQK / 16; ++e) n += (e >= NQR) ? 3 : 2; return n;
}
template <int DQK, int NQR, int QD, int D> __device__ __forceinline__ void qk_step(f32x16& p0, f32x16& p1, const int (&ka)[4], int qaddr, const bf16x8* qr,
                                                                                bf16x8 (&B0)[QD + 1], bf16x8 (&B1)[QD + 1], bf16x8 (&Q)[QD + 1]) {
  constexpr int N = DQK / 16;
  if constexpr (D + QD < N) qk_issue<DQK, NQR, D + QD>(ka, qaddr, B0[(D + QD) % (QD + 1)], B1[(D + QD) % (QD + 1)], Q[(D + QD) % (QD + 1)]);
  lgkm_wait<qk_reads_after<DQK, NQR, QD>(D)>(); SBAR();
  bf16x8 qf; if constexpr (D < NQR) qf = qr[D < NQR ? D : 0]; else qf = Q[D % (QD + 1)];
  if constexpr (D == 0) { p0 = __builtin_amdgcn_mfma_f32_32x32x16_bf16(B0[0], qf, f32x16{}, 0, 0, 0); p1 = __builtin_amdgcn_mfma_f32_32x32x16_bf16(B1[0], qf, f32x16{}, 0, 0, 0); }
  else { p0 = __builtin_amdgcn_mfma_f32_32x32x16_bf16(B0[D % (QD + 1)], qf, p0, 0, 0, 0); p1 = __builtin_amdgcn_mfma_f32_32x32x16_bf16(B1[D % (QD + 1)], qf, p1, 0, 0, 0); }
  SBAR();
  if constexpr (D + 1 < N) qk_step<DQK, NQR, QD, D + 1>(p0, p1, ka, qaddr, qr, B0, B1, Q);
}
template <int DQK, int NQR, int QD> __device__ __forceinline__ void qk_pipe(f32x16& p0, f32x16& p1, int kbase, const int (&kx)[4], int qaddr, const bf16x8* qr) {
  int ka[4];
#pragma unroll
  for (int j = 0; j < 4; ++j) ka[j] = kbase + kx[j];
  bf16x8 B0[QD + 1], B1[QD + 1], Q[QD + 1];
  SBAR();
#pragma unroll
  for (int d = 0; d < QD; ++d) { if (d == 0) qk_issue<DQK, NQR, 0>(ka, qaddr, B0[0], B1[0], Q[0]); if (d == 1) qk_issue<DQK, NQR, 1>(ka, qaddr, B0[1 % (QD + 1)], B1[1 % (QD + 1)], Q[1 % (QD + 1)]); }
  qk_step<DQK, NQR, QD, 0>(p0, p1, ka, qaddr, qr, B0, B1, Q);
}
template <int DV, int D0> __device__ __forceinline__ void pv_one(f32x16& od, int vb, bf16x8 pa0, bf16x8 pa1, bf16x8 pa2, bf16x8 pa3) {
  const s16x4 l0 = tr_read<v_rd_off<DV>(D0, 0, 0)>(vb), h0 = tr_read<v_rd_off<DV>(D0, 0, 1)>(vb), l1 = tr_read<v_rd_off<DV>(D0, 1, 0)>(vb), h1 = tr_read<v_rd_off<DV>(D0, 1, 1)>(vb);
  const s16x4 l2 = tr_read<v_rd_off<DV>(D0, 2, 0)>(vb), h2 = tr_read<v_rd_off<DV>(D0, 2, 1)>(vb), l3 = tr_read<v_rd_off<DV>(D0, 3, 0)>(vb), h3 = tr_read<v_rd_off<DV>(D0, 3, 1)>(vb);
  asm volatile("s_waitcnt lgkmcnt(0)" ::: "memory"); SBAR();
#define PK(L, H) (bf16x8){L[0], L[1], L[2], L[3], H[0], H[1], H[2], H[3]}
  od = __builtin_amdgcn_mfma_f32_32x32x16_bf16(pa0, PK(l0, h0), od, 0, 0, 0);
  od = __builtin_amdgcn_mfma_f32_32x32x16_bf16(pa1, PK(l1, h1), od, 0, 0, 0);
  od = __builtin_amdgcn_mfma_f32_32x32x16_bf16(pa2, PK(l2, h2), od, 0, 0, 0);
  od = __builtin_amdgcn_mfma_f32_32x32x16_bf16(pa3, PK(l3, h3), od, 0, 0, 0);
#undef PK
}
template <int DV> __device__ __forceinline__ void pv_all(f32x16* o, int vb, bf16x8 pa0, bf16x8 pa1, bf16x8 pa2, bf16x8 pa3) {
  pv_one<DV, 0>(o[0], vb, pa0, pa1, pa2, pa3); pv_one<DV, 1>(o[1], vb, pa0, pa1, pa2, pa3);
  if constexpr (DV == 128) { pv_one<DV, 2>(o[2], vb, pa0, pa1, pa2, pa3); pv_one<DV, 3>(o[3], vb, pa0, pa1, pa2, pa3); }
}
__device__ __forceinline__ void smA(f32x16& p, float& m_reg, float& alpha, const float C, const float thrS) {
  float pmax = p[0];
#pragma unroll
  for (int r = 1; r < 16; ++r) pmax = fmaxf(pmax, p[r]);
  { auto rr = __builtin_amdgcn_permlane32_swap(__float_as_uint(pmax), __float_as_uint(pmax), false, false);
    pmax = fmaxf(__uint_as_float(rr[0]), __uint_as_float(rr[1])); }
  float mn;
  if (__builtin_expect(__all(pmax - m_reg <= thrS), 1)) { mn = m_reg; alpha = 1.f; }
  else { mn = fmaxf(m_reg, pmax); alpha = __builtin_amdgcn_exp2f((m_reg - mn) * C); m_reg = mn; }
  const float mnC = -mn * C;
#pragma unroll
  for (int r = 0; r < 16; ++r) p[r] = __builtin_amdgcn_exp2f(fmaf(p[r], C, mnC));
}
__device__ __forceinline__ void smB(const f32x16& p, float alpha, float& l_reg, bf16x8& pa0, bf16x8& pa1) {
  float ps = 0;
#pragma unroll
  for (int r = 0; r < 16; ++r) ps += p[r];
  { auto rr = __builtin_amdgcn_permlane32_swap(__float_as_uint(ps), __float_as_uint(ps), false, false);
    ps = __uint_as_float(rr[0]) + __uint_as_float(rr[1]); }
  l_reg = l_reg * alpha + ps;
#define PK4(P, BASE, OUT) do { unsigned a0 = cvtpk(P[BASE + 0], P[BASE + 1]), a1 = cvtpk(P[BASE + 2], P[BASE + 3]);   \
    unsigned b0 = cvtpk(P[BASE + 4], P[BASE + 5]), b1 = cvtpk(P[BASE + 6], P[BASE + 7]);                              \
    auto r0 = __builtin_amdgcn_permlane32_swap(a0, b0, false, false); auto r1 = __builtin_amdgcn_permlane32_swap(a1, b1, false, false); \
    u32x4 w = {r0[0], r1[0], r0[1], r1[1]}; OUT = *reinterpret_cast<bf16x8*>(&w); } while (0)
  PK4(p, 0, pa0); PK4(p, 8, pa1);
#undef PK4
}
template <int DQK, int NQR>
__device__ __forceinline__ void qk_half(f32x16& p, const char* Ks, int rb, const bf16x8* qr, const char* qls, int r32, int hi) {
  p = f32x16{};
#pragma unroll
  for (int d0 = 0; d0 < DQK / 16; ++d0) { const int cb = (d0 * 16 + hi * 8) * 2;
    bf16x8 b0 = *reinterpret_cast<const bf16x8*>(Ks + kswz<DQK>(rb + r32, cb));
    bf16x8 qf; if (d0 < NQR) qf = qr[d0]; else qf = *reinterpret_cast<const bf16x8*>(qls + (d0 - NQR) * 1024);
    p = __builtin_amdgcn_mfma_f32_32x32x16_bf16(b0, qf, p, 0, 0, 0); }
}
template <int DV, int D0, int KS0> __device__ __forceinline__ void pvh_one(f32x16& od, int vb, bf16x8 pa0, bf16x8 pa1) {
  const s16x4 l0 = tr_read<v_rd_off<DV>(D0, KS0, 0)>(vb), h0 = tr_read<v_rd_off<DV>(D0, KS0, 1)>(vb), l1 = tr_read<v_rd_off<DV>(D0, KS0 + 1, 0)>(vb), h1 = tr_read<v_rd_off<DV>(D0, KS0 + 1, 1)>(vb);
  asm volatile("s_waitcnt lgkmcnt(0)" ::: "memory"); SBAR();
#define PK(L, H) (bf16x8){L[0], L[1], L[2], L[3], H[0], H[1], H[2], H[3]}
  od = __builtin_amdgcn_mfma_f32_32x32x16_bf16(pa0, PK(l0, h0), od, 0, 0, 0);
  od = __builtin_amdgcn_mfma_f32_32x32x16_bf16(pa1, PK(l1, h1), od, 0, 0, 0);
#undef PK
}
template <int DV, int KS0> __device__ __forceinline__ void pv_half(f32x16* o, int vb, bf16x8 pa0, bf16x8 pa1) {
  pvh_one<DV, 0, KS0>(o[0], vb, pa0, pa1); pvh_one<DV, 1, KS0>(o[1], vb, pa0, pa1);
  if constexpr (DV == 128) { pvh_one<DV, 2, KS0>(o[2], vb, pa0, pa1); pvh_one<DV, 3, KS0>(o[3], vb, pa0, pa1); }
}
__device__ __forceinline__ void na_mask_half(f32x16& p, int kr, int coff, int qrow_g, int qc, int hi, const float* btab) {
  const int rs = min(max(qrow_g - 4, 0), 120), cs = min(max(qc - 8, 0), 48);
  const bool rowok = (kr >= rs) && (kr < rs + 8);
  const int ri = min(max(kr - qrow_g + 7, 0), 14);
  const float* brow = btab + ri * 31;
#pragma unroll
  for (int i = 0; i < 16; ++i) {
    const int kc = coff + crow(i, hi);
    const bool ok = rowok && kc >= cs && kc < cs + 16;
    const float bv = brow[min(max(kc - qc + 15, 0), 30)];
    p[i] = ok ? p[i] + bv : -1e30f;
  }
}
__device__ __forceinline__ void na_mask(f32x16& p0, f32x16& p1, int kr, int qrow_g, int qc, int hi, const float* btab) {
  const int rs = min(max(qrow_g - 4, 0), 120), cs = min(max(qc - 8, 0), 48);
  const bool rowok = (kr >= rs) && (kr < rs + 8);
  const int ri = min(max(kr - qrow_g + 7, 0), 14);
  const float* brow = btab + ri * 31;
#pragma unroll
  for (int i = 0; i < 16; ++i) {
    const int kc0 = crow(i, hi), kc1 = 32 + kc0;
    const bool ok0 = rowok && kc0 >= cs && kc0 < cs + 16, ok1 = rowok && kc1 >= cs && kc1 < cs + 16;
    const float b0 = brow[min(max(kc0 - qc + 15, 0), 30)], b1 = brow[min(max(kc1 - qc + 15, 0), 30)];
    p0[i] = ok0 ? p0[i] + b0 : -1e30f; p1[i] = ok1 ? p1[i] + b1 : -1e30f;
  }
}

struct NoFill { template <int D, int NSTEP> __device__ __forceinline__ void run() const {} };
struct ExpFill { f32x16* p; float C, mnC;
  template <int D, int NSTEP> __device__ __forceinline__ void run() const {
    constexpr int e0 = 16 * D / NSTEP, e1 = 16 * (D + 1) / NSTEP;
#pragma unroll
    for (int e = e0; e < e1; ++e) (*p)[e] = __builtin_amdgcn_exp2f(fmaf((*p)[e], C, mnC));
  } };
#define SBARV() __builtin_amdgcn_sched_barrier(0x0406)
template <int DV, int KS0, int I> __device__ __forceinline__ void pvh_issue(int vb, s16x4& l, s16x4& h) {
  constexpr int ND0 = DV / 32, ks = KS0 + I / ND0, d0 = I % ND0;
  l = tr_read<v_rd_off<DV>(d0, ks, 0)>(vb); h = tr_read<v_rd_off<DV>(d0, ks, 1)>(vb);
}
template <int DV, int KS0, int I, class Fill> __device__ __forceinline__ void pvh_step(f32x16* o, int vb, const bf16x8 (&pa)[2], s16x4 (&L)[4], s16x4 (&H)[4], const Fill& F) {
  constexpr int ND0 = DV / 32, NM = 2 * ND0, kk = I / ND0, d0 = I % ND0;
  if constexpr (I + 3 < NM) pvh_issue<DV, KS0, I + 3>(vb, L[(I + 3) & 3], H[(I + 3) & 3]);
  constexpr int ahead = (NM - 1 - I) < 3 ? (NM - 1 - I) : 3;
  lgkm_wait<2 * ahead>(); SBAR();
  const s16x4 l = L[I & 3], h = H[I & 3];
  o[d0] = __builtin_amdgcn_mfma_f32_32x32x16_bf16(pa[kk], (bf16x8){l[0], l[1], l[2], l[3], h[0], h[1], h[2], h[3]}, o[d0], 0, 0, 0);
  SBAR();
  F.template run<I, NM>();
  SBAR();
  if constexpr (I + 1 < NM) pvh_step<DV, KS0, I + 1, Fill>(o, vb, pa, L, H, F);
}
template <int DV, int KS0, class Fill> __device__ __forceinline__ void pvh_pipe(f32x16* o, int vb, bf16x8 pa0, bf16x8 pa1, const Fill& F) {
  const bf16x8 pa[2] = {pa0, pa1}; s16x4 L[4], H[4];
  SBAR();
  pvh_issue<DV, KS0, 0>(vb, L[0], H[0]); pvh_issue<DV, KS0, 1>(vb, L[1], H[1]); pvh_issue<DV, KS0, 2>(vb, L[2], H[2]);
  pvh_step<DV, KS0, 0, Fill>(o, vb, pa, L, H, F);
}
template <int DQK, int NQR, int HALF_, int D> __device__ __forceinline__ void qkh_issue(const int (&ka)[4], int qaddr, bf16x8& b, bf16x8& q) {
  constexpr int off = (D >> 2) * 128 + HALF_ * 32 * DQK * 2;
  b = lds_read128<off>(ka[D & 3]);
  if constexpr (D >= NQR) q = lds_read128<(D - NQR) * 1024>(qaddr);
}
template <int DQK, int NQR, int A> constexpr int qkh_reads_after(int d) {
  int n = 0; for (int e = d + 1; e <= d + A && e < DQK / 16; ++e) n += (e >= NQR) ? 2 : 1; return n;
}
template <int DQK, int NQR, int HALF_, int D, class Fill> __device__ __forceinline__ void qkh_step(f32x16& p, const int (&ka)[4], int qaddr, const bf16x8* qr, bf16x8 (&B)[4], bf16x8 (&Q)[4], const Fill& F) {
  constexpr int N = DQK / 16, QDH = 3;
  if constexpr (D + QDH < N) qkh_issue<DQK, NQR, HALF_, D + QDH>(ka, qaddr, B[(D + QDH) & 3], Q[(D + QDH) & 3]);
  lgkm_wait<qkh_reads_after<DQK, NQR, QDH>(D)>(); SBAR();
  bf16x8 qf; if constexpr (D < NQR) qf = qr[D < NQR ? D : 0]; else qf = Q[D & 3];
  if constexpr (D == 0) p = __builtin_amdgcn_mfma_f32_32x32x16_bf16(B[0], qf, f32x16{}, 0, 0, 0);
  else p = __builtin_amdgcn_mfma_f32_32x32x16_bf16(B[D & 3], qf, p, 0, 0, 0);
  SBAR();
  F.template run<D, N>();
  SBAR();
  if constexpr (D + 1 < N) qkh_step<DQK, NQR, HALF_, D + 1, Fill>(p, ka, qaddr, qr, B, Q, F);
}
template <int DQK, int NQR, int HALF_, class Fill> __device__ __forceinline__ void qkh_pipe(f32x16& p, int kbase, const int (&kx)[4], int qaddr, const bf16x8* qr, const Fill& F) {
  int ka[4];
#pragma unroll
  for (int j = 0; j < 4; ++j) ka[j] = kbase + kx[j];
  bf16x8 B[4], Q[4];
  SBAR();
  qkh_issue<DQK, NQR, HALF_, 0>(ka, qaddr, B[0], Q[0]); qkh_issue<DQK, NQR, HALF_, 1>(ka, qaddr, B[1], Q[1]); qkh_issue<DQK, NQR, HALF_, 2>(ka, qaddr, B[2], Q[2]);
  qkh_step<DQK, NQR, HALF_, 0, Fill>(p, ka, qaddr, qr, B, Q, F);
}
__device__ __forceinline__ float smA_pre(const f32x16& p, float& m_reg, float& alpha, const float C, const float thrS) {
  float pmax = p[0];
#pragma unroll
  for (int r = 1; r < 16; ++r) pmax = fmaxf(pmax, p[r]);
  { auto rr = __builtin_amdgcn_permlane32_swap(__float_as_uint(pmax), __float_as_uint(pmax), false, false);
    pmax = fmaxf(__uint_as_float(rr[0]), __uint_as_float(rr[1])); }
  float mn;
  if (__builtin_expect(__all(pmax - m_reg <= thrS), 1)) { mn = m_reg; alpha = 1.f; }
  else { mn = fmaxf(m_reg, pmax); alpha = __builtin_amdgcn_exp2f((m_reg - mn) * C); m_reg = mn; }
  return -mn * C;
}
template <int DQK, int DV, int NQL, bool NA>
__device__ __forceinline__ void attn_unit(const bf16_t* __restrict__ Qb, int ldq, const bf16_t* __restrict__ Kh, int ldk, const bf16_t* __restrict__ Vh, int ldv,
                                          bf16_t* __restrict__ Ob, int ldo, int NT, int skip, float scale, int na_r0, int na_krlo, char* lds, LAS unsigned char* ldsl) {
  constexpr int SHM_V = 64 * DV * 2, SHM_K = 64 * DQK * 2, NKC = DQK / 64, NVC = DV / 64, ND0 = DV / 32, NQ = DQK / 16, NQR = NQ - NQL, RING = 3 * (SHM_V + SHM_K);
  int tid_ = threadIdx.x; asm volatile("" : "+v"(tid_));
  const int tid = tid_, wid = __builtin_amdgcn_readfirstlane(tid >> 6), lane = tid & 63, r32 = lane & 31, hi = lane >> 5;
  char* V_lds = lds; char* K_lds = lds + 3 * SHM_V;
  float* ws = (float*)(lds + RING) + wid * 64; float* li_l = ws; float* al_l = ws + 32;
  char* qls = lds + RING + 2048 + wid * (NQL * 1024) + lane * 16;
  const float* btab = (const float*)(lds + 98304);
  const float C = scale * 1.4426950408889634f, thrS = THRN / scale;
  float m_reg = -1e30f, l_reg = 0; f32x16 o[ND0]; bf16x8 qr[NQR];
#pragma unroll
  for (int d = 0; d < ND0; ++d) o[d] = f32x16{};
  const bf16_t* Qw = Qb + (long)(wid * 32 + r32) * ldq + hi * 8;
#pragma unroll
  for (int d0 = 0; d0 < NQR; ++d0) qr[d0] = *reinterpret_cast<const bf16x8*>(Qw + d0 * 16);
#pragma unroll
  for (int d0 = 0; d0 < NQL; ++d0) *reinterpret_cast<bf16x8*>(qls + d0 * 1024) = *reinterpret_cast<const bf16x8*>(Qw + (NQR + d0) * 16);
  int kgo[NKC], vgo[NVC];
#pragma unroll
  for (int i = 0; i < NKC; ++i) { const int P = 64 * (wid + 8 * i) + lane, slot = P / (DQK / 8), row = slot ^ ((slot >> 4) & 1), cpos = P % (DQK / 8), cc = cpos ^ (row & 7); kgo[i] = row * ldk + cc * 8; }
#pragma unroll
  for (int i = 0; i < NVC; ++i) { const int P = 64 * (wid + 8 * i) + lane, sidx = P >> 5, within = P & 31, kk = (sidx / (DV / 32)) * 8 + (within >> 2), k = (kk & ~0xC) | ((kk & 4) << 1) | ((kk & 8) >> 1);
    vgo[i] = k * ldv + (sidx % (DV / 32)) * 32 + (within & 3) * 8; }
  const int vb0 = (int)(uintptr_t)V_lds + v_rd_base(lane);
  constexpr int QD = (NQL > 0) ? 1 : 2;
  const int kl0 = (int)(uintptr_t)K_lds + (r32 ^ ((r32 >> 4) & 1)) * (DQK * 2), qaddr = (int)(uintptr_t)qls;
  int kx[4];
#pragma unroll
  for (int j = 0; j < 4; ++j) kx[j] = (j * 32 + hi * 16) ^ ((r32 & 7) << 4);
  const int qrow_g = na_r0 + (wid >> 1), qc = 32 * (wid & 1) + r32;
#define KEY0(t) (64 * (t) + ((NA && (t) >= 4) ? skip : 0))
#define DMA(t, b) do { const long k0_ = KEY0(t); _Pragma("unroll") for (int i_ = 0; i_ < NVC; ++i_) \
      __builtin_amdgcn_global_load_lds((const unsigned*)(Vh + k0_ * ldv + vgo[i_]), (LAS unsigned*)(ldsl + (b) * SHM_V + (wid + 8 * i_) * 1024), 16, 0, 0); \
    _Pragma("unroll") for (int i_ = 0; i_ < NKC; ++i_) \
      __builtin_amdgcn_global_load_lds((const unsigned*)(Kh + k0_ * ldk + kgo[i_]), (LAS unsigned*)(ldsl + 3 * SHM_V + (b) * SHM_K + (wid + 8 * i_) * 1024), 16, 0, 0); } while (0)
#define RESC(a) do { if (__any((a) < 1.f)) { if (hi == 0) al_l[r32] = (a); asm volatile("s_waitcnt lgkmcnt(0)" ::: "memory"); \
    _Pragma("unroll") for (int d = 0; d < ND0; ++d) _Pragma("unroll") for (int r = 0; r < 16; ++r) o[d][r] *= al_l[crow(r, hi)]; } } while (0)
#define MASK(pa_, pb_, t) do { if constexpr (NA) { if ((t) >= 4) na_mask(pa_, pb_, na_krlo + (t) - 4, qrow_g, qc, hi, btab); } } while (0)
#define MASKH(p_, t, coff) do { if constexpr (NA) { if ((t) >= 4) na_mask_half(p_, na_krlo + (t) - 4, coff, qrow_g, qc, hi, btab); } } while (0)
#ifdef ATT_PINGPONG
  f32x16 p0, p1; float mn, al; bf16x8 pa0, pa1, pa2, pa3;
  const bool halfB = wid >= 4;
#define BARRIER() do { asm volatile("s_waitcnt lgkmcnt(0)" ::: "memory"); __builtin_amdgcn_s_barrier(); asm volatile("" ::: "memory"); } while (0)
#define XPOINT(t) do { asm volatile("s_waitcnt vmcnt(0)" ::: "memory"); BARRIER(); if ((t) + 2 < NT) { int fb_ = ((t) + 2) % 3; DMA((t) + 2, fb_); } } while (0)
  DMA(0, 0); if (1 < NT) DMA(1, 1);
  asm volatile("s_waitcnt vmcnt(0)" ::: "memory"); BARRIER();
  if (halfB) BARRIER();
  int buf = 0, pbuf = 0;
  for (int t = 0; t < NT; ++t) {
    SBAR();
    if (t > 0) pv_pipe<DV>(o, vb0 + pbuf * SHM_V, pa0, pa1, pa2, pa3);
    qk_pipe<DQK, NQR, QD>(p0, p1, kl0 + buf * SHM_K, kx, qaddr, qr);
    SBAR();
    if (halfB) XPOINT(t); else BARRIER();
    MASK(p0, p1, t);
    partialSM(p0, p1, m_reg, mn, al, C, thrS);
    RESC(al);
    finishSM(p0, p1, al, l_reg, pa0, pa1, pa2, pa3);
    SBAR();
    if (halfB) BARRIER(); else XPOINT(t);
    pbuf = buf; buf = buf + 1; if (buf == 3) buf = 0;
  }
  pv_pipe<DV>(o, vb0 + pbuf * SHM_V, pa0, pa1, pa2, pa3);
  asm volatile("s_waitcnt lgkmcnt(0)" ::: "memory");
  if (!halfB) BARRIER();
#undef BARRIER
#undef XPOINT
#elif defined(ATT_HALVES)
  f32x16 pA, pB; float alA, alB; bf16x8 pa0, pa1, pa2, pa3;
  DMA(0, 0); if (1 < NT) DMA(1, 1);
  asm volatile("s_waitcnt vmcnt(0) lgkmcnt(0)" ::: "memory"); __builtin_amdgcn_s_barrier(); asm volatile("" ::: "memory");
  int buf = 0;
  for (int t = 0; t < NT; ++t) {
    SBAR();
    qkh_pipe<DQK, NQR, 0>(pA, kl0 + buf * SHM_K, kx, qaddr, qr, NoFill{});
    MASKH(pA, t, 0);
    const float mnCa = smA_pre(pA, m_reg, alA, C, thrS);
    RESC(alA);
    SBAR();
    qkh_pipe<DQK, NQR, 1>(pB, kl0 + buf * SHM_K, kx, qaddr, qr, ExpFill{&pA, C, mnCa});
    smB(pA, alA, l_reg, pa0, pa1);
    MASKH(pB, t, 32);
    const float mnCb = smA_pre(pB, m_reg, alB, C, thrS);
    SBAR();
    pvh_pipe<DV, 0>(o, vb0 + buf * SHM_V, pa0, pa1, ExpFill{&pB, C, mnCb});
    smB(pB, alB, l_reg, pa2, pa3);
    RESC(alB);
    SBAR();
    pvh_pipe<DV, 2>(o, vb0 + buf * SHM_V, pa2, pa3, NoFill{});
    asm volatile("s_waitcnt vmcnt(0) lgkmcnt(0)" ::: "memory"); __builtin_amdgcn_s_barrier(); asm volatile("" ::: "memory");
    if (t + 2 < NT) { int fb_ = (t + 2) % 3; DMA(t + 2, fb_); }
    buf = buf + 1; if (buf == 3) buf = 0;
  }
#else
  f32x16 p0, p1; float mn, al; bf16x8 pa0, pa1, pa2, pa3;
  DMA(0, 0); if (1 < NT) DMA(1, 1);
  asm volatile("s_waitcnt vmcnt(0) lgkmcnt(0)" ::: "memory"); __builtin_amdgcn_s_barrier(); asm volatile("" ::: "memory");
  int buf = 0;
  for (int t = 0; t < NT; ++t) {
    bool act = true;
    if constexpr (NA) { if (t >= 4) { const int kr_ = na_krlo + t - 4, rs_ = min(max(qrow_g - 4, 0), 120); act = (kr_ >= rs_) && (kr_ < rs_ + 8); } }
    if (act) {
    qk_pipe<DQK, NQR, QD>(p0, p1, kl0 + buf * SHM_K, kx, qaddr, qr);
    MASK(p0, p1, t);
    partialSM(p0, p1, m_reg, mn, al, C, thrS);
    RESC(al);
    finishSM(p0, p1, al, l_reg, pa0, pa1, pa2, pa3);
    pv_pipe<DV>(o, vb0 + buf * SHM_V, pa0, pa1, pa2, pa3);
    }
    asm volatile("s_waitcnt vmcnt(0) lgkmcnt(0)" ::: "memory"); __builtin_amdgcn_s_barrier(); asm volatile("" ::: "memory");
    if (t + 2 < NT) { int fb_ = (t + 2) % 3; DMA(t + 2, fb_); }
    buf = buf + 1; if (buf == 3) buf = 0;
  }
#endif
  if (hi == 0) li_l[r32] = l_reg; asm volatile("s_waitcnt lgkmcnt(0)" ::: "memory");
  float rli[16];
#pragma unroll
  for (int r = 0; r < 16; ++r) rli[r] = __builtin_amdgcn_rcpf(li_l[crow(r, hi)]);
  bf16_t* Ow = Ob + (long)(wid * 32) * ldo;
#pragma unroll
  for (int r = 0; r < 16; ++r) { const int orow = crow(r, hi);
#pragma unroll
    for (int d0 = 0; d0 < ND0; ++d0) { const float v = o[d0][r] * rli[r]; unsigned u = __builtin_bit_cast(unsigned, v); u = (u + 0x7fffu + ((u >> 16) & 1u)) >> 16; Ow[(long)orow * ldo + d0 * 32 + r32] = (bf16_t)u; } }
  __syncthreads();
#undef KEY0
#undef DMA
#undef RESC
#undef MASK
#undef MASKH
}

template <int OFF> __device__ __forceinline__ long lds_read64(int addr) {
  long r; asm volatile("ds_read_b64 %0, %1 offset:%2" : "=&v"(r) : "v"(addr), "i"(OFF) : "memory"); return r;
}
template <int D> __device__ __forceinline__ void qk8_issue(const int (&ka)[4], long& b0, long& b1) {
  constexpr int off = (D >> 2) * 64;
  b0 = lds_read64<off>(ka[D & 3]); b1 = lds_read64<off + 32 * 192>(ka[D & 3]);
}
template <int D> __device__ __forceinline__ void qk8_step(f32x16& p0, f32x16& p1, const int (&ka)[4], const long* qr, long (&B0)[3], long (&B1)[3]) {
  constexpr int N = 12, QD8 = 2;
  if constexpr (D + QD8 < N) qk8_issue<D + QD8>(ka, B0[(D + QD8) % 3], B1[(D + QD8) % 3]);
  constexpr int after = (N - 1 - D) < QD8 ? (N - 1 - D) : QD8;
  lgkm_wait<2 * after>(); SBAR();
  if constexpr (D == 0) { p0 = __builtin_amdgcn_mfma_f32_32x32x16_fp8_fp8(B0[0], qr[0], f32x16{}, 0, 0, 0); p1 = __builtin_amdgcn_mfma_f32_32x32x16_fp8_fp8(B1[0], qr[0], f32x16{}, 0, 0, 0); }
  else { p0 = __builtin_amdgcn_mfma_f32_32x32x16_fp8_fp8(B0[D % 3], qr[D], p0, 0, 0, 0); p1 = __builtin_amdgcn_mfma_f32_32x32x16_fp8_fp8(B1[D % 3], qr[D], p1, 0, 0, 0); }
  SBAR();
  if constexpr (D + 1 < N) qk8_step<D + 1>(p0, p1, ka, qr, B0, B1);
}
__device__ __forceinline__ void qk8_pipe(f32x16& p0, f32x16& p1, int kbase, const int (&kx)[4], const long* qr) {
  int ka[4];
#pragma unroll
  for (int j = 0; j < 4; ++j) ka[j] = kbase + kx[j];
  long B0[3], B1[3];
  SBAR();
  qk8_issue<0>(ka, B0[0], B1[0]); qk8_issue<1>(ka, B0[1], B1[1]);
  qk8_step<0>(p0, p1, ka, qr, B0, B1);
}
__device__ __forceinline__ void attn_unit_f8k(const unsigned char* __restrict__ Qb, const unsigned char* __restrict__ Kh, const bf16_t* __restrict__ Vh, int ldv,
                                              bf16_t* __restrict__ Ob, int ldo, int NT, float scale, char* lds, LAS unsigned char* ldsl) {
  constexpr int DV = 128, LDB = 1536, SHM_V = 64 * DV * 2, SHM_K = 64 * 192, NVC = 2, ND0 = 4, RING = 3 * (SHM_V + SHM_K);
  int tid_ = threadIdx.x; asm volatile("" : "+v"(tid_));
  const int tid = tid_, wid = __builtin_amdgcn_readfirstlane(tid >> 6), lane = tid & 63, r32 = lane & 31, hi = lane >> 5;
  char* V_lds = lds; char* K_lds = lds + 3 * SHM_V;
  float* ws = (float*)(lds + RING) + wid * 64; float* li_l = ws; float* al_l = ws + 32;
  const float C = scale * 1.4426950408889634f, thrS = THRN / scale;
  float m_reg = -1e30f, l_reg = 0; f32x16 o[ND0]; long qr[12];
#pragma unroll
  for (int d = 0; d < ND0; ++d) o[d] = f32x16{};
  const unsigned char* Qw = Qb + (long)(wid * 32 + r32) * LDB + hi * 8;
#pragma unroll
  for (int d0 = 0; d0 < 12; ++d0) qr[d0] = *(const __attribute__((address_space(1))) long*)(Qw + d0 * 16);
  int kgo[2], vgo[NVC];
#pragma unroll
  for (int i = 0; i < 2; ++i) { const int P = 64 * (wid + 8 * i) + lane, slot = P / 12, cpos = P - slot * 12, row = slot ^ ((slot >> 4) & 1), c16 = cpos ^ ((slot >> 2) & 3); kgo[i] = row * LDB + c16 * 16; }
#pragma unroll
  for (int i = 0; i < NVC; ++i) { const int P = 64 * (wid + 8 * i) + lane, sidx = P >> 5, within = P & 31, kk = (sidx / (DV / 32)) * 8 + (within >> 2), k = (kk & ~0xC) | ((kk & 4) << 1) | ((kk & 8) >> 1);
    vgo[i] = k * ldv + (sidx % (DV / 32)) * 32 + (within & 3) * 8; }
  const int vb0 = (int)(uintptr_t)V_lds + v_rd_base(lane);
  const int slot32 = r32 ^ ((r32 >> 4) & 1);
  const int kl0 = (int)(uintptr_t)K_lds + slot32 * 192 + hi * 8;
  int kx[4];
#pragma unroll
  for (int j = 0; j < 4; ++j) kx[j] = (j ^ ((slot32 >> 2) & 3)) * 16;
#define DMA8(t, b) do { const long k0_ = 64 * (long)(t); _Pragma("unroll") for (int i_ = 0; i_ < NVC; ++i_) \
      __builtin_amdgcn_global_load_lds((const unsigned*)(Vh + k0_ * ldv + vgo[i_]), (LAS unsigned*)(ldsl + (b) * SHM_V + (wid + 8 * i_) * 1024), 16, 0, 0); \
    __builtin_amdgcn_global_load_lds((const unsigned*)(Kh + k0_ * LDB + kgo[0]), (LAS unsigned*)(ldsl + 3 * SHM_V + (b) * SHM_K + wid * 1024), 16, 0, 0); \
    if (wid < 4) __builtin_amdgcn_global_load_lds((const unsigned*)(Kh + k0_ * LDB + kgo[1]), (LAS unsigned*)(ldsl + 3 * SHM_V + (b) * SHM_K + (wid + 8) * 1024), 16, 0, 0); } while (0)
#define RESC8(a) do { if (__any((a) < 1.f)) { if (hi == 0) al_l[r32] = (a); asm volatile("s_waitcnt lgkmcnt(0)" ::: "memory"); \
    _Pragma("unroll") for (int d = 0; d < ND0; ++d) _Pragma("unroll") for (int r = 0; r < 16; ++r) o[d][r] *= al_l[crow(r, hi)]; } } while (0)
  f32x16 p0, p1; float mn, al; bf16x8 pa0, pa1, pa2, pa3;
  DMA8(0, 0); if (1 < NT) DMA8(1, 1);
  asm volatile("s_waitcnt vmcnt(0) lgkmcnt(0)" ::: "memory"); __builtin_amdgcn_s_barrier(); asm volatile("" ::: "memory");
  int buf = 0;
  for (int t = 0; t < NT; ++t) {
    qk8_pipe(p0, p1, kl0 + buf * SHM_K, kx, qr);
    partialSM(p0, p1, m_reg, mn, al, C, thrS);
    RESC8(al);
    finishSM(p0, p1, al, l_reg, pa0, pa1, pa2, pa3);
    pv_pipe<DV>(o, vb0 + buf * SHM_V, pa0, pa1, pa2, pa3);
    asm volatile("s_waitcnt vmcnt(0) lgkmcnt(0)" ::: "memory"); __builtin_amdgcn_s_barrier(); asm volatile("" ::: "memory");
    if (t + 2 < NT) { int fb_ = (t + 2) % 3; DMA8(t + 2, fb_); }
    buf = buf + 1; if (buf == 3) buf = 0;
  }
  if (hi == 0) li_l[r32] = l_reg; asm volatile("s_waitcnt lgkmcnt(0)" ::: "memory");
  float rli[16];
#pragma unroll
  for (int r = 0; r < 16; ++r) rli[r] = __builtin_amdgcn_rcpf(li_l[crow(r, hi)]);
  bf16_t* Ow = Ob + (long)(wid * 32) * ldo;
#pragma unroll
  for (int r = 0; r < 16; ++r) { const int orow = crow(r, hi);
#pragma unroll
    for (int d0 = 0; d0 < ND0; ++d0) { const float v = o[d0][r] * rli[r]; unsigned u = __builtin_bit_cast(unsigned, v); u = (u + 0x7fffu + ((u >> 16) & 1u)) >> 16; Ow[(long)orow * ldo + d0 * 32 + r32] = (bf16_t)u; } }
  __syncthreads();
#undef DMA8
#undef RESC8
}

__device__ __forceinline__ long pack_p8(const f32x16& p, int base) {
  int a = __builtin_amdgcn_cvt_pk_fp8_f32(p[base + 0], p[base + 1], 0, false); a = __builtin_amdgcn_cvt_pk_fp8_f32(p[base + 2], p[base + 3], a, true);
  int b = __builtin_amdgcn_cvt_pk_fp8_f32(p[base + 4], p[base + 5], 0, false); b = __builtin_amdgcn_cvt_pk_fp8_f32(p[base + 6], p[base + 7], b, true);
  auto r = __builtin_amdgcn_permlane32_swap((unsigned)a, (unsigned)b, false, false);
  return (long)(((unsigned long long)r[1] << 32) | (unsigned long long)r[0]);
}
template <int I> __device__ __forceinline__ void pv8_issue(int vb, const int (&vx)[4], long& v) {
  constexpr int s_ = I >> 2, d0 = I & 3;
  v = lds_read64<d0 * 2048>(vb + vx[s_]);
}
template <int I> __device__ __forceinline__ void pv8_step(f32x16* o, int vb, const int (&vx)[4], const long (&pa)[4], long (&V)[4]) {
  constexpr int NM = 16, s_ = I >> 2, d0 = I & 3;
  if constexpr (I + 3 < NM) pv8_issue<I + 3>(vb, vx, V[(I + 3) & 3]);
  constexpr int ahead = (NM - 1 - I) < 3 ? (NM - 1 - I) : 3;
  lgkm_wait<ahead>(); SBAR();
  o[d0] = __builtin_amdgcn_mfma_f32_32x32x16_fp8_fp8(pa[s_], V[I & 3], o[d0], 0, 0, 0);
  SBAR();
  if constexpr (I + 1 < NM) pv8_step<I + 1>(o, vb, vx, pa, V);
}
__device__ __forceinline__ void pv8_pipe(f32x16* o, int vb, const int (&vx)[4], const long (&pa)[4]) {
  long V[4];
  SBAR();
  pv8_issue<0>(vb, vx, V[0]); pv8_issue<1>(vb, vx, V[1]); pv8_issue<2>(vb, vx, V[2]);
  pv8_step<0>(o, vb, vx, pa, V);
}
__device__ __forceinline__ void attn_unit_f8kv(const unsigned char* __restrict__ Qb, const unsigned char* __restrict__ Kh, const unsigned char* __restrict__ Vt,
                                               bf16_t* __restrict__ Ob, int ldo, int NT, float scale, char* lds, LAS unsigned char* ldsl) {
  constexpr int LDB = 1536, SHM_V = 8192, SHM_K = 64 * 192, ND0 = 4, RING = 3 * (SHM_V + SHM_K);
  constexpr float THR8 = 5.5f;
  int tid_ = threadIdx.x; asm volatile("" : "+v"(tid_));
  const int tid = tid_, wid = __builtin_amdgcn_readfirstlane(tid >> 6), lane = tid & 63, r32 = lane & 31, hi = lane >> 5;
  char* V_lds = lds; char* K_lds = lds + 3 * SHM_V;
  float* ws = (float*)(lds + RING) + wid * 64; float* li_l = ws; float* al_l = ws + 32;
  const float C = scale * 1.4426950408889634f, thrS = THR8 / scale;
  float m_reg = -1e30f, l_reg = 0; f32x16 o[ND0]; long qr[12];
#pragma unroll
  for (int d = 0; d < ND0; ++d) o[d] = f32x16{};
  const unsigned char* Qw = Qb + (long)(wid * 32 + r32) * LDB + hi * 8;
#pragma unroll
  for (int d0 = 0; d0 < 12; ++d0) qr[d0] = *(const __attribute__((address_space(1))) long*)(Qw + d0 * 16);
  int kgo[2], vgo;
#pragma unroll
  for (int i = 0; i < 2; ++i) { const int P = 64 * (wid + 8 * i) + lane, slot = P / 12, cpos = P - slot * 12, row = slot ^ ((slot >> 4) & 1), c16 = cpos ^ ((slot >> 2) & 3); kgo[i] = row * LDB + c16 * 16; }
  { const int P = 64 * wid + lane, slot = P >> 2, cpos = P & 3, d = slot ^ ((slot >> 4) & 1), c16 = cpos ^ ((slot >> 2) & 3); vgo = d * 64 + c16 * 16; }
  const int slot32 = r32 ^ ((r32 >> 4) & 1), asw = (slot32 >> 2) & 3;
  const int kl0 = (int)(uintptr_t)K_lds + slot32 * 192 + hi * 8;
  const int vl0 = (int)(uintptr_t)V_lds + slot32 * 64 + hi * 8;
  int kx[4], vx[4];
#pragma unroll
  for (int j = 0; j < 4; ++j) { kx[j] = (j ^ asw) * 16; vx[j] = (j ^ asw) * 16; }
#define DMA8(t, b) do { const long t_ = (long)(t); \
    __builtin_amdgcn_global_load_lds((const unsigned*)(Vt + t_ * 8192 + vgo), (LAS unsigned*)(ldsl + (b) * SHM_V + wid * 1024), 16, 0, 0); \
    __builtin_amdgcn_global_load_lds((const unsigned*)(Kh + t_ * 64 * LDB + kgo[0]), (LAS unsigned*)(ldsl + 3 * SHM_V + (b) * SHM_K + wid * 1024), 16, 0, 0); \
    if (wid < 4) __builtin_amdgcn_global_load_lds((const unsigned*)(Kh + t_ * 64 * LDB + kgo[1]), (LAS unsigned*)(ldsl + 3 * SHM_V + (b) * SHM_K + (wid + 8) * 1024), 16, 0, 0); } while (0)
#define RESC8(a) do { if (__any((a) < 1.f)) { if (hi == 0) al_l[r32] = (a); asm volatile("s_waitcnt lgkmcnt(0)" ::: "memory"); \
    _Pragma("unroll") for (int d = 0; d < ND0; ++d) _Pragma("unroll") for (int r = 0; r < 16; ++r) o[d][r] *= al_l[crow(r, hi)]; } } while (0)
  f32x16 p0, p1; float mn, al;
  DMA8(0, 0); if (1 < NT) DMA8(1, 1);
  asm volatile("s_waitcnt vmcnt(0) lgkmcnt(0)" ::: "memory"); __builtin_amdgcn_s_barrier(); asm volatile("" ::: "memory");
  int buf = 0;
  for (int t = 0; t < NT; ++t) {
    qk8_pipe(p0, p1, kl0 + buf * SHM_K, kx, qr);
    partialSM(p0, p1, m_reg, mn, al, C, thrS);
    RESC8(al);
#pragma unroll
    for (int r = 0; r < 16; ++r) p1[r] = __builtin_amdgcn_exp2f(p1[r]);
    float ps = 0;
#pragma unroll
    for (int r = 0; r < 16; ++r) ps += p0[r];
#pragma unroll
    for (int r = 0; r < 16; ++r) ps += p1[r];
    { auto rr = __builtin_amdgcn_permlane32_swap(__float_as_uint(ps), __float_as_uint(ps), false, false); ps = __uint_as_float(rr[0]) + __uint_as_float(rr[1]); }
    l_reg = l_reg * al + ps;
    const long pa[4] = {pack_p8(p0, 0), pack_p8(p0, 8), pack_p8(p1, 0), pack_p8(p1, 8)};
    pv8_pipe(o, vl0 + buf * SHM_V, vx, pa);
    asm volatile("s_waitcnt vmcnt(0) lgkmcnt(0)" ::: "memory"); __builtin_amdgcn_s_barrier(); asm volatile("" ::: "memory");
    if (t + 2 < NT) { int fb_ = (t + 2) % 3; DMA8(t + 2, fb_); }
    buf = buf + 1; if (buf == 3) buf = 0;
  }
  if (hi == 0) li_l[r32] = l_reg; asm volatile("s_waitcnt lgkmcnt(0)" ::: "memory");
  float rli[16];
#pragma unroll
  for (int r = 0; r < 16; ++r) rli[r] = __builtin_amdgcn_rcpf(li_l[crow(r, hi)]);
  bf16_t* Ow = Ob + (long)(wid * 32) * ldo;
#pragma unroll
  for (int r = 0; r < 16; ++r) { const int orow = crow(r, hi);
#pragma unroll
    for (int d0 = 0; d0 < ND0; ++d0) { const float v = o[d0][r] * rli[r]; unsigned u = __builtin_bit_cast(unsigned, v); u = (u + 0x7fffu + ((u >> 16) & 1u)) >> 16; Ow[(long)orow * ldo + d0 * 32 + r32] = (bf16_t)u; } }
  __syncthreads();
#undef DMA8
#undef RESC8
}

typedef int i32x8 __attribute__((ext_vector_type(8)));
typedef int i32x4 __attribute__((ext_vector_type(4)));
template <int OFF> __device__ __forceinline__ i32x4 lds_read128i(int addr) {
  i32x4 r; asm volatile("ds_read_b128 %0, %1 offset:%2" : "=&v"(r) : "v"(addr), "i"(OFF) : "memory"); return r;
}
__device__ __forceinline__ i32x8 cat8(const i32x4 a, const i32x4 b) { return (i32x8){a[0], a[1], a[2], a[3], b[0], b[1], b[2], b[3]}; }
#define MFMA_S8(A_, B_, C_) __builtin_amdgcn_mfma_scale_f32_32x32x64_f8f6f4(A_, B_, C_, 0, 0, 0, 127, 0, 127)
template <int S> __device__ __forceinline__ void qks_issue(const int (&ka)[2], i32x4& x0, i32x4& x1) {
  constexpr int c = S >> 1, half = S & 1, off = c * 64 + half * 32 * 192;
  x0 = lds_read128i<off>(ka[0]); x1 = lds_read128i<off>(ka[1]);
}
template <int S> __device__ __forceinline__ void qks_step(f32x16& p0, f32x16& p1, const int (&ka)[2], const i32x8* qv, i32x4 (&X0)[3], i32x4 (&X1)[3]) {
  constexpr int N = 6, c = S >> 1, half = S & 1;
  if constexpr (S + 2 < N) qks_issue<S + 2>(ka, X0[(S + 2) % 3], X1[(S + 2) % 3]);
  constexpr int after = (N - 1 - S) < 2 ? (N - 1 - S) : 2;
  lgkm_wait<2 * after>(); SBAR();
  const i32x8 kf = cat8(X0[S % 3], X1[S % 3]);
  if constexpr (half == 0) { if constexpr (c == 0) p0 = MFMA_S8(kf, qv[c], f32x16{}); else p0 = MFMA_S8(kf, qv[c], p0); }
  else { if constexpr (c == 0) p1 = MFMA_S8(kf, qv[c], f32x16{}); else p1 = MFMA_S8(kf, qv[c], p1); }
  SBAR();
  if constexpr (S + 1 < N) qks_step<S + 1>(p0, p1, ka, qv, X0, X1);
}
template <int D0> __device__ __forceinline__ void pvs_issue(const int (&va)[2], i32x4& x0, i32x4& x1) { x0 = lds_read128i<D0 * 2048>(va[0]); x1 = lds_read128i<D0 * 2048>(va[1]); }
template <int D0> __device__ __forceinline__ void pvs_step(f32x16* o, const int (&va)[2], const i32x8& pf, i32x4 (&X0)[3], i32x4 (&X1)[3]) {
  constexpr int N = 4;
  if constexpr (D0 + 2 < N) pvs_issue<D0 + 2>(va, X0[(D0 + 2) % 3], X1[(D0 + 2) % 3]);
  constexpr int after = (N - 1 - D0) < 2 ? (N - 1 - D0) : 2;
  lgkm_wait<2 * after>(); SBAR();
  o[D0] = MFMA_S8(pf, cat8(X0[D0 % 3], X1[D0 % 3]), o[D0]);
  SBAR();
  if constexpr (D0 + 1 < N) pvs_step<D0 + 1>(o, va, pf, X0, X1);
}
__device__ __forceinline__ int pack4_fp8(float a, float b, float c, float d) { int w = __builtin_amdgcn_cvt_pk_fp8_f32(a, b, 0, false); return __builtin_amdgcn_cvt_pk_fp8_f32(c, d, w, true); }
__device__ __forceinline__ void attn_unit_f8s(const unsigned char* __restrict__ Qb, const unsigned char* __restrict__ Kh, const unsigned char* __restrict__ Vt,
                                              bf16_t* __restrict__ Ob, int ldo, int NT, float scale, char* lds, LAS unsigned char* ldsl) {
  constexpr int LDB = 1536, SHM_V = 8192, SHM_K = 64 * 192, ND0 = 4, RING = 3 * (SHM_V + SHM_K);
  constexpr float THR8 = 5.5f;
  int tid_ = threadIdx.x; asm volatile("" : "+v"(tid_));
  const int tid = tid_, wid = __builtin_amdgcn_readfirstlane(tid >> 6), lane = tid & 63, r32 = lane & 31, hi = lane >> 5;
  char* V_lds = lds; char* K_lds = lds + 3 * SHM_V;
  float* ws = (float*)(lds + RING) + wid * 64; float* li_l = ws; float* al_l = ws + 32;
  const float C = scale * 1.4426950408889634f, thrS = THR8 / scale;
  float m_reg = -1e30f, l_reg = 0; f32x16 o[ND0]; i32x8 qv[3];
#pragma unroll
  for (int d = 0; d < ND0; ++d) o[d] = f32x16{};
  const unsigned char* Qw = Qb + (long)(wid * 32 + r32) * LDB + hi * 32;
#pragma unroll
  for (int c = 0; c < 3; ++c) qv[c] = cat8(*(const __attribute__((address_space(1))) i32x4*)(Qw + c * 64), *(const __attribute__((address_space(1))) i32x4*)(Qw + c * 64 + 16));
  int kgo[2], vgo;
#pragma unroll
  for (int i = 0; i < 2; ++i) { const int P = 64 * (wid + 8 * i) + lane, slot = P / 12, cpos = P - slot * 12, row = slot ^ ((slot >> 4) & 1), c16 = cpos ^ ((slot >> 2) & 3); kgo[i] = row * LDB + c16 * 16; }
  { const int P = 64 * wid + lane, slot = P >> 2, cpos = P & 3, d = slot ^ ((slot >> 4) & 1), c16 = cpos ^ ((slot >> 2) & 3); vgo = d * 64 + c16 * 16; }
  const int slot32 = r32 ^ ((r32 >> 4) & 1), asw = (slot32 >> 2) & 3;
  const int kl0 = (int)(uintptr_t)K_lds + slot32 * 192, vl0 = (int)(uintptr_t)V_lds + slot32 * 64;
  int xo[2];
#pragma unroll
  for (int e = 0; e < 2; ++e) xo[e] = ((2 * hi + e) ^ asw) * 16;
#define DMA8(t, b) do { const long t_ = (long)(t); \
    __builtin_amdgcn_global_load_lds((const unsigned*)(Vt + t_ * 8192 + vgo), (LAS unsigned*)(ldsl + (b) * SHM_V + wid * 1024), 16, 0, 0); \
    __builtin_amdgcn_global_load_lds((const unsigned*)(Kh + t_ * 64 * LDB + kgo[0]), (LAS unsigned*)(ldsl + 3 * SHM_V + (b) * SHM_K + wid * 1024), 16, 0, 0); \
    if (wid < 4) __builtin_amdgcn_global_load_lds((const unsigned*)(Kh + t_ * 64 * LDB + kgo[1]), (LAS unsigned*)(ldsl + 3 * SHM_V + (b) * SHM_K + (wid + 8) * 1024), 16, 0, 0); } while (0)
#define RESC8(a) do { if (__any((a) < 1.f)) { if (hi == 0) al_l[r32] = (a); asm volatile("s_waitcnt lgkmcnt(0)" ::: "memory"); \
    _Pragma("unroll") for (int d = 0; d < ND0; ++d) _Pragma("unroll") for (int r = 0; r < 16; ++r) o[d][r] *= al_l[crow(r, hi)]; } } while (0)
  f32x16 p0, p1; float mn, al;
  DMA8(0, 0); if (1 < NT) DMA8(1, 1);
  asm volatile("s_waitcnt vmcnt(0) lgkmcnt(0)" ::: "memory"); __builtin_amdgcn_s_barrier(); asm volatile("" ::: "memory");
  int buf = 0;
  for (int t = 0; t < NT; ++t) {
    { int ka[2]; ka[0] = kl0 + buf * SHM_K + xo[0]; ka[1] = kl0 + buf * SHM_K + xo[1];
      i32x4 X0[3], X1[3];
      SBAR();
      qks_issue<0>(ka, X0[0], X1[0]); qks_issue<1>(ka, X0[1], X1[1]);
      qks_step<0>(p0, p1, ka, qv, X0, X1); }
    partialSM(p0, p1, m_reg, mn, al, C, thrS);
    RESC8(al);
#pragma unroll
    for (int r = 0; r < 16; ++r) p1[r] = __builtin_amdgcn_exp2f(p1[r]);
    float ps = 0;
#pragma unroll
    for (int r = 0; r < 16; ++r) ps += p0[r];
#pragma unroll
    for (int r = 0; r < 16; ++r) ps += p1[r];
    { auto rr = __builtin_amdgcn_permlane32_swap(__float_as_uint(ps), __float_as_uint(ps), false, false); ps = __uint_as_float(rr[0]) + __uint_as_float(rr[1]); }
    l_reg = l_reg * al + ps;
    const i32x8 pf = {pack4_fp8(p0[0], p0[1], p0[2], p0[3]), pack4_fp8(p0[4], p0[5], p0[6], p0[7]), pack4_fp8(p0[8], p0[9], p0[10], p0[11]), pack4_fp8(p0[12], p0[13], p0[14], p0[15]),
                      pack4_fp8(p1[0], p1[1], p1[2], p1[3]), pack4_fp8(p1[4], p1[5], p1[6], p1[7]), pack4_fp8(p1[8], p1[9], p1[10], p1[11]), pack4_fp8(p1[12], p1[13], p1[14], p1[15])};
    { int va[2]; va[0] = vl0 + buf * SHM_V + xo[0]; va[1] = vl0 + buf * SHM_V + xo[1];
      i32x4 X0[3], X1[3];
      SBAR();
      pvs_issue<0>(va, X0[0], X1[0]); pvs_issue<1>(va, X0[1], X1[1]);
      pvs_step<0>(o, va, pf, X0, X1); }
    asm volatile("s_waitcnt vmcnt(0) lgkmcnt(0)" ::: "memory"); __builtin_amdgcn_s_barrier(); asm volatile("" ::: "memory");
    if (t + 2 < NT) { int fb_ = (t + 2) % 3; DMA8(t + 2, fb_); }
    buf = buf + 1; if (buf == 3) buf = 0;
  }
  if (hi == 0) li_l[r32] = l_reg; asm volatile("s_waitcnt lgkmcnt(0)" ::: "memory");
  float rli[16];
#pragma unroll
  for (int r = 0; r < 16; ++r) rli[r] = __builtin_amdgcn_rcpf(li_l[crow(r, hi)]);
  bf16_t* Ow = Ob + (long)(wid * 32) * ldo;
#pragma unroll
  for (int r = 0; r < 16; ++r) { const int orow = crow(r, hi);
#pragma unroll
    for (int d0 = 0; d0 < ND0; ++d0) { const float v = o[d0][r] * rli[r]; unsigned u = __builtin_bit_cast(unsigned, v); u = (u + 0x7fffu + ((u >> 16) & 1u)) >> 16; Ow[(long)orow * ldo + d0 * 32 + r32] = (bf16_t)u; } }
  __syncthreads();
#undef DMA8
#undef RESC8
}
}
#define XB_TMO      128
#define XB_XCNT(j)  (256  + 64 * (j))
#define XB_XSUB(j)  (1280 + 64 * (j))
#define XB_XGEN(j)  (2304 + 64 * (j))
#define XB_TOP      3328
#define XB_TOPGEN   3392
#define XCD_BAR_WORDS 3456
#define XB_SPIN_CAP (1u << 22)

__device__ __forceinline__ unsigned xb_ld(unsigned* p)              { return __hip_atomic_load(p, __ATOMIC_RELAXED, __HIP_MEMORY_SCOPE_AGENT); }
__device__ __forceinline__ unsigned xb_add(unsigned* p, unsigned v) { return __hip_atomic_fetch_add(p, v, __ATOMIC_RELAXED, __HIP_MEMORY_SCOPE_AGENT); }
__device__ __forceinline__ unsigned xb_xcc_id() { return (unsigned)__builtin_amdgcn_s_getreg((3 << 11) | 20) & 0xFu; }
#define XB_SPIN(cond, bar) do { unsigned _sp = 0; while (cond) { __builtin_amdgcn_s_sleep(1); \
    if ((++_sp & 255u) == 0u) { if (xb_ld(&(bar)[XB_TMO])) break; if (_sp > XB_SPIN_CAP) { atomicAdd(&(bar)[XB_TMO], 1u); break; } } } } while (0)

struct XcdBarrier {
    unsigned* bar; unsigned x;
    volatile LAS unsigned* st;
};

__device__ __forceinline__ XcdBarrier xcd_barrier_post(unsigned* bar, volatile LAS unsigned* st) {
    XcdBarrier b; b.bar = bar; b.x = xb_xcc_id(); b.st = st;
    if (threadIdx.x == 0) (void)xb_add(&bar[XB_XCNT(b.x)], 1u);
    return b;
}
__device__ __forceinline__ void xcd_barrier_complete(unsigned* bar, unsigned x, unsigned& nloc, unsigned& nx) {
    const unsigned G = gridDim.x * gridDim.y * gridDim.z;
    unsigned sum, cnt, mine, sp = 0u;
    for (;;) {
        sum = 0u; cnt = 0u; mine = 0u;
#pragma unroll
        for (unsigned j = 0; j < 16; ++j) { const unsigned c = xb_ld(&bar[XB_XCNT(j)]); sum += c; cnt += (c > 0u) ? 1u : 0u; mine = (j == x) ? c : mine; }
        if (sum == G) break;
        __builtin_amdgcn_s_sleep(1);
        if ((++sp & 255u) == 0u) { if (xb_ld(&bar[XB_TMO])) break; if (sp > XB_SPIN_CAP) { atomicAdd(&bar[XB_TMO], 1u); break; } }
    }
    nloc = mine > 0u ? mine : 1u; nx = cnt > 0u ? cnt : 1u;
}

__device__ __forceinline__ void xcd_barrier(const XcdBarrier& b) {
    asm volatile("s_waitcnt vmcnt(0)" ::: "memory");
    __syncthreads();
    if (threadIdx.x == 0) {
        unsigned* bar = b.bar;
        __builtin_amdgcn_s_waitcnt(0);
        unsigned nloc = b.st[0], nx = b.st[1];
        if (nloc == 0u) { xcd_barrier_complete(bar, b.x, nloc, nx); b.st[0] = nloc; b.st[1] = nx; }
        const unsigned old = xb_add(&bar[XB_XSUB(b.x)], 1u);
        const unsigned gen = old / nloc;
        if (old + 1u == (gen + 1u) * nloc) {
            __builtin_amdgcn_fence(__ATOMIC_RELEASE, "agent");
            asm volatile("s_waitcnt vmcnt(0)" ::: "memory");
            const unsigned og = xb_add(&bar[XB_TOP], 1u);
            const unsigned tg = og / nx;
            if (og + 1u == (tg + 1u) * nx) xb_add(&bar[XB_TOPGEN], 1u);
            else XB_SPIN(xb_ld(&bar[XB_TOPGEN]) == tg, bar);
            __builtin_amdgcn_fence(__ATOMIC_ACQUIRE, "agent");
            xb_add(&bar[XB_XGEN(b.x)], 1u);
            asm volatile("s_waitcnt vmcnt(0)" ::: "memory");
        } else {
            XB_SPIN(xb_ld(&bar[XB_XGEN(b.x)]) == gen, bar);
            __builtin_amdgcn_fence(__ATOMIC_ACQUIRE, "agent");
            asm volatile("s_waitcnt vmcnt(0)" ::: "memory");
        }
    }
    __syncthreads();
}
typedef unsigned short bf16_t;
typedef float f32x4 __attribute__((ext_vector_type(4)));
typedef unsigned u32x4 __attribute__((ext_vector_type(4)));
typedef unsigned u32x2 __attribute__((ext_vector_type(2)));
#define LDS_WAIT() asm volatile("s_waitcnt lgkmcnt(0)" ::: "memory")
__device__ __forceinline__ unsigned f2bf(float f) { unsigned u = __builtin_bit_cast(unsigned, f); return (u + 0x7fffu + ((u >> 16) & 1u)) >> 16; }
__device__ __forceinline__ unsigned pk2(float lo, float hi) { return f2bf(lo) | (f2bf(hi) << 16); }
__device__ __forceinline__ float bf2f(unsigned short h) { return __builtin_bit_cast(float, (unsigned)h << 16); }
__device__ __forceinline__ float wave_sum(float v) {
#pragma unroll
    for (int o = 1; o < 64; o <<= 1) v += __shfl_xor(v, o);
    return v;
}
struct Args { const float* in[27]; float* out; unsigned char* ws; };
enum { I_X = 0, I_C, I_CTX, I_CCTX, I_WMOD, I_BMOD, I_NORMG, I_WG, I_WU, I_WDN, I_AIN, I_AQN, I_AKVN, I_AUQ, I_AUKV, I_AOUT, I_BQKV, I_BLQ1, I_BLK1, I_BLQ2, I_BLK2, I_BSUB, I_BOUT, I_CQKV, I_CRPB, I_COUT, I_FING };

__device__ __forceinline__ void tr_item(const float* W, int Nsrc, int K, int k0, int srccol0, bf16_t* WT, int g0, LAS float* scr, int lane) {
    if (srccol0 >= 0) {
        float v[32];
        const float* wp = W + (size_t)(k0 + (lane >> 5)) * Nsrc + srccol0 + (lane & 31);
#pragma unroll
        for (int i = 0; i < 32; ++i) v[i] = wp[(size_t)(2 * i) * Nsrc];
#pragma unroll
        for (int i = 0; i < 32; ++i) { const int kk = 2 * i + (lane >> 5); scr[kk * 33 + (lane & 31)] = v[i]; }
    } else {
#pragma unroll 8
        for (int i = 0; i < 32; ++i) { const int kk = 2 * i + (lane >> 5); scr[kk * 33 + (lane & 31)] = 0.f; }
    }
    LDS_WAIT(); asm volatile("" ::: "memory");
    const int c = lane & 7;
#pragma unroll
    for (int j = 0; j < 4; ++j) { const int n = (lane >> 3) + 8 * j; const LAS float* s = scr + (8 * c) * 33 + n;
        u32x4 o; o.x = pk2(s[0 * 33], s[1 * 33]); o.y = pk2(s[2 * 33], s[3 * 33]); o.z = pk2(s[4 * 33], s[5 * 33]); o.w = pk2(s[6 * 33], s[7 * 33]);
        *(u32x4*)(WT + (size_t)(g0 + n) * K + k0 + 8 * c) = o; }
    LDS_WAIT(); asm volatile("" ::: "memory");
}

struct PrepItem { const float* W; int Nsrc, K, k0, src; bf16_t* WT; int g0; };
__device__ __forceinline__ PrepItem prep_decode(const Args& A, int r) {
    unsigned char* ws = A.ws; PrepItem t;
    constexpr int IT_GU = 16 * 176, IT_D = 44 * 32, IT_FFN = IT_GU + IT_D;
    constexpr int IT_AIN = 16 * 16, IT_AUQ = 4 * 48, IT_AUKV = 2 * 64, IT_AOUT = 16 * 32, IT_MLA = IT_AIN + IT_AUQ + IT_AUKV + IT_AOUT;
    constexpr int IT_QKV = 16 * 96, IT_OUT = 16 * 32;
    if (r < 8 * IT_FFN) {
        const int fi = r / IT_FFN; r -= fi * IT_FFN;
        if (r < IT_GU) { const int kb = r / 176, gb = r % 176, g = 32 * gb, pn = g >> 8, bj = (g >> 7) & 1, o = g & 127;
            t = PrepItem{(bj ? A.in[I_WU] : A.in[I_WG]) + (size_t)fi * 1024 * DFF, DFF, 1024, 64 * kb, 128 * pn + o, (bf16_t*)(ws + O_WGU + fi * SZ_WGU), g}; }
        else { r -= IT_GU; const int kb = r / 32, gb = r % 32;
            t = PrepItem{A.in[I_WDN] + (size_t)fi * DFF * 1024, 1024, DFF, 64 * kb, 32 * gb, (bf16_t*)(ws + O_WD + fi * SZ_WD), 32 * gb}; }
        return t;
    }
    r -= 8 * IT_FFN;
    if (r < 2 * IT_MLA) {
        const int j = r / IT_MLA; r -= j * IT_MLA;
        if (r < IT_AIN) { const int kb = r / 16, gb = r % 16, g = 32 * gb;
            return PrepItem{A.in[I_AIN] + (size_t)j * 1024 * 448, 448, 1024, 64 * kb, g < 448 ? g : -1, (bf16_t*)(ws + O_AIN + (size_t)j * 512 * 1024 * 2), g}; }
        r -= IT_AIN;
        if (r < IT_AUQ) { const int kb = r / 48, gb = r % 48, g = 32 * gb; int col;
            if (g < 1024) col = (g >> 7) * 192 + (g & 127);
            else { const int g2 = g - 1024, p = g2 >> 8, half = (g2 >> 7) & 1, hh = (g2 >> 5) & 3; col = (4 * p + hh) * 192 + 128 + 32 * half; }
            return PrepItem{A.in[I_AUQ] + (size_t)j * 256 * 1536, 1536, 256, 64 * kb, col, (bf16_t*)(ws + O_AUQ + (size_t)j * 1536 * 256 * 2), g}; }
        r -= IT_AUQ;
        if (r < IT_AUKV) { const int kb = r / 64, gb = r % 64;
            return PrepItem{A.in[I_AUKV] + (size_t)j * 128 * 2048, 2048, 128, 64 * kb, 32 * gb, (bf16_t*)(ws + O_AUKV + (size_t)j * 2048 * 128 * 2), 32 * gb}; }
        r -= IT_AUKV;
        { const int kb = r / 32, gb = r % 32;
            return PrepItem{A.in[I_AOUT] + (size_t)j * 1024 * 1024, 1024, 1024, 64 * kb, 32 * gb, (bf16_t*)(ws + O_AOUT + (size_t)j * 1024 * 1024 * 2), 32 * gb}; }
    }
    r -= 2 * IT_MLA;
    if (r < IT_QKV) { const int kb = r / 96, gb = r % 96, g = 32 * gb; int col = g;
        if (g < 2048) { const int pn = g >> 8, half = (g >> 7) & 1, hh = (g >> 5) & 3; col = 256 * pn + 64 * hh + 32 * half; }
        return PrepItem{A.in[I_BQKV], 3072, 1024, 64 * kb, col, (bf16_t*)(ws + O_BQKV), g}; }
    r -= IT_QKV;
    if (r < IT_OUT) { const int kb = r / 32, gb = r % 32; return PrepItem{A.in[I_BOUT], 1024, 1024, 64 * kb, 32 * gb, (bf16_t*)(ws + O_BOUT), 32 * gb}; }
    r -= IT_OUT;
    if (r < IT_QKV) { const int kb = r / 96, gb = r % 96; return PrepItem{A.in[I_CQKV], 3072, 1024, 64 * kb, 32 * gb, (bf16_t*)(ws + O_CQKV), 32 * gb}; }
    r -= IT_QKV;
    { const int kb = r / 32, gb = r % 32; return PrepItem{A.in[I_COUT], 1024, 1024, 64 * kb, 32 * gb, (bf16_t*)(ws + O_COUT), 32 * gb}; }
}
__device__ __forceinline__ void prep_load(const PrepItem& t, float (&x)[32], int lane) {
    if (t.src >= 0) { const float* wp = t.W + (size_t)(t.k0 + (lane >> 5)) * t.Nsrc + t.src + (lane & 31);
#pragma unroll
        for (int i = 0; i < 32; ++i) x[i] = wp[(size_t)(2 * i) * t.Nsrc]; }
    else {
#pragma unroll
        for (int i = 0; i < 32; ++i) x[i] = 0.f; }
}
__device__ __forceinline__ void prep_finish(const PrepItem& t, const float (&x)[32], LAS float* scr, int lane) {
#pragma unroll
    for (int i = 0; i < 32; ++i) { const int kk = 2 * i + (lane >> 5); scr[kk * 33 + (lane & 31)] = x[i]; }
    LDS_WAIT(); asm volatile("" ::: "memory");
    const int c = lane & 7;
#pragma unroll
    for (int j = 0; j < 4; ++j) { const int n = (lane >> 3) + 8 * j; const LAS float* sp = scr + (8 * c) * 33 + n;
        u32x4 o; o.x = pk2(sp[0 * 33], sp[1 * 33]); o.y = pk2(sp[2 * 33], sp[3 * 33]); o.z = pk2(sp[4 * 33], sp[5 * 33]); o.w = pk2(sp[6 * 33], sp[7 * 33]);
        *(u32x4*)(t.WT + (size_t)(t.g0 + n) * t.K + t.k0 + 8 * c) = o; }
    LDS_WAIT(); asm volatile("" ::: "memory");
}
__device__ __forceinline__ void prep_weights(const Args& A, LAS float* scr, int gw, int NGW, int lane, int a0, int alen, int b0, int vbeg, int vend) {
    int v = vbeg + gw;
    if (v >= vend) return;
    PrepItem cur = prep_decode(A, v < alen ? a0 + v : b0 + (v - alen)); float xc[32];
    prep_load(cur, xc, lane);
    for (;;) {
        const int vn = v + NGW; const bool has = vn < vend; PrepItem nx = cur; float xn[32];
        if (has) { nx = prep_decode(A, vn < alen ? a0 + vn : b0 + (vn - alen)); prep_load(nx, xn, lane); }
        prep_finish(cur, xc, scr, lane);
        if (!has) break;
        cur = nx; v = vn;
#pragma unroll
        for (int i = 0; i < 32; ++i) xc[i] = xn[i];
    }
}

enum { K_NOP = 0, K_NORM, K_GEMM_B, K_GEMM_F, K_MLAMID, K_ATT_A, K_ATT_B, K_ATT_C, K_DIFFFIN, K_FINAL };

__global__ void __launch_bounds__(512, 2) fwd_mega(Args args) {
    extern __shared__ __attribute__((aligned(16))) unsigned char lds_raw[];
    cg::grid_group grid = cg::this_grid();
    LAS unsigned char* lds = (LAS unsigned char*)lds_raw;
    const int tid = threadIdx.x, lane = tid & 63, wave = __builtin_amdgcn_readfirstlane(tid >> 6);
    const int G = gridDim.x, bid = blockIdx.x;
    const int gw = bid * 8 + wave, NGW = G * 8;
    unsigned char* ws = args.ws;
    float* MOD = (float*)(ws + O_MOD); float* ROPE = (float*)(ws + O_ROPE); float* S = (float*)(ws + O_S);

    volatile LAS unsigned* MISC = (volatile LAS unsigned*)(lds + LDS_MISC);
    if (threadIdx.x < 64) MISC[threadIdx.x] = 0u;
    __syncthreads();
    XcdBarrier xbar = xcd_barrier_post((unsigned*)(ws + O_CTL), MISC + 8);
    if (threadIdx.x == 0) MISC[16] = __hip_atomic_fetch_add((unsigned*)(ws + O_CTL) + 3584 + 64 * xbar.x, 1u, __ATOMIC_RELAXED, __HIP_MEMORY_SCOPE_AGENT);
#ifndef PROBE_DUP
#define PROBE_DUP 0
#endif
    for (int p0rep = 0; p0rep < ((PROBE_DUP & 64) ? 2 : 1); ++p0rep) {
        int tid_ = threadIdx.x; asm volatile("" : "+v"(tid_)); const int tid = tid_, lane = tid & 63;
        LAS float* sc = (LAS float*)lds;
        for (int i = tid; i < 3072; i += 512) { const int mi = i >> 10, k = i & 1023; const float v = mi < 2 ? args.in[I_C][mi * 1024 + k] : args.in[I_CCTX][k]; sc[i] = v / (1.f + __expf(-v)); }
        __syncthreads();
        LAS float* red = (LAS float*)(lds + 16384);
        const int cl = tid & 15, kg = tid >> 4;
        for (int item = bid; item < 576; item += G) {
            const int l = item / 144, n0 = (item % 144) * 64;
            const float* W = args.in[I_WMOD] + (size_t)l * 1024 * 9216 + n0 + 4 * cl;
            f32x4 a0 = {0.f, 0.f, 0.f, 0.f}, a1 = a0, a2 = a0;
#pragma unroll 8
            for (int kk = 0; kk < 32; ++kk) { const int k = kg * 32 + kk; const f32x4 w = *(const f32x4*)(W + (size_t)k * 9216); a0 += sc[k] * w; a1 += sc[1024 + k] * w; a2 += sc[2048 + k] * w; }
            *(LAS f32x4*)(red + (kg * 3 + 0) * 64 + 4 * cl) = a0; *(LAS f32x4*)(red + (kg * 3 + 1) * 64 + 4 * cl) = a1; *(LAS f32x4*)(red + (kg * 3 + 2) * 64 + 4 * cl) = a2;
            __syncthreads();
            if (tid < 192) { const int mi = tid >> 6, col = tid & 63; float s = args.in[I_BMOD][l * 9216 + n0 + col];
                for (int k2 = 0; k2 < 32; ++k2) s += red[(k2 * 3 + mi) * 64 + col];
                MOD[(size_t)(l * 3 + mi) * 9216 + n0 + col] = s; }
            __syncthreads();
        }
        prep_weights(args, (LAS float*)(lds + wave * 16384), gw, NGW, lane, 0, 8448, 33792, 0, 8448 + 1088);
        { const int idx = bid * 512 + tid; if (idx < 2048) { const int pos = idx >> 4, m = idx & 15;
#ifndef DIS_ROPE
 const float inv = powf(10000.0f, -(float)m / 16.0f); const float ang = (float)pos * inv; ROPE[idx] = cosf(ang); ROPE[2048 + idx] = sinf(ang);
#endif
 } }
    }
    grid.sync();
    int vcu = bid;
    {
        bool even = (G % 8) == 0;
        for (int j = 0; j < 8; ++j) even = even && (__hip_atomic_load((unsigned*)(ws + O_CTL) + 3584 + 64 * j, __ATOMIC_RELAXED, __HIP_MEMORY_SCOPE_AGENT) == (unsigned)(G / 8));
        if (even && xbar.x < 8u) vcu = (int)xbar.x + 8 * (int)MISC[16];
    }

    bool second = false;
    for (int ph = 0; ph < DEPTH * 13 + 1; ++ph) {
        int kind = K_NOP; bool sync_after = true;
        const int L = ph / 13, st = ph - L * 13, mk = L % 3, mj = L / 3;
        unsigned char* ws = args.ws; asm volatile("" : "+s"(ws));
        float* S = (float*)(ws + O_S); bf16_t* H = (bf16_t*)(ws + O_H); unsigned char* X = ws + O_X;
        float* MOD = (float*)(ws + O_MOD); float* ROPE = (float*)(ws + O_ROPE);
        int tid_ = threadIdx.x; asm volatile("" : "+v"(tid_));
        const int tid = tid_, lane = tid & 63, wave = __builtin_amdgcn_readfirstlane(tid >> 6);
        const int gw = bid * 8 + wave, NGW = G * 8;
        size_t aoff = 0, boff = 0; int gN = 0, gK = 0, emode = 0, modoff = 0;
        int nslot = 0, pnsp = 0, pmodoff = 0; float pcoef = 0.f;
        const float* modL = MOD + (size_t)L * 3 * 9216;
        if (ph == DEPTH * 13) kind = K_FINAL;
        else if (st == 0 || st == 3 || st == 10) { kind = K_NORM; nslot = st == 0 ? 0 : (st == 3 ? 1 : 2);
            if (st == 0) { pnsp = L > 0 ? 11 : 0; pmodoff = (L - 1) * 3 * 9216 + 8 * 1024; pcoef = 0.5f; }
            else if (st == 3) { pnsp = 11; pmodoff = L * 3 * 9216 + 2 * 1024; pcoef = 0.5f; }
            else { pnsp = (L == DEPTH - 1) ? 0 : 4; pmodoff = L * 3 * 9216 + 5 * 1024; pcoef = 1.0f; } }
        else if (st == 1 || st == 11) { kind = K_GEMM_B; aoff = O_H; boff = O_WGU + (size_t)(L * 2 + (st == 11)) * SZ_WGU; gN = 5632; gK = 1024; emode = 0; }
        else if (st == 2 || st == 12) { kind = K_GEMM_F; aoff = O_X; boff = O_WD + (size_t)(L * 2 + (st == 12)) * SZ_WD; gN = 1024; gK = DFF; emode = 0; modoff = L * 3 * 9216 + (st == 2 ? 2 : 8) * 1024; }
        else if (mk == 0) {
            if (st == 4) { kind = K_GEMM_F; aoff = O_H; boff = O_AIN + (size_t)mj * 512 * 1024 * 2; gN = 512; gK = 1024; emode = 1; }
            else if (st == 5) kind = K_MLAMID;
            else if (st == 6) { kind = K_GEMM_B; aoff = O_X + XA_CQN; boff = O_AUQ + (size_t)mj * 1536 * 256 * 2; gN = 1536; gK = 256; emode = 4; sync_after = false; }
            else if (st == 7) { kind = K_GEMM_B; aoff = O_X + XA_CKVN; boff = O_AUKV + (size_t)mj * 2048 * 128 * 2; gN = 2048; gK = 128; emode = 3; }
            else if (st == 8) kind = K_ATT_A;
            else if (st == 9) { kind = K_GEMM_F; aoff = O_X + XA_O; boff = O_AOUT + (size_t)mj * 1024 * 1024 * 2; gN = 1024; gK = 1024; emode = 2; modoff = L * 3 * 9216 + 5 * 1024; }
        } else if (mk == 1) {
            if (st == 4) { kind = K_GEMM_B; aoff = O_H; boff = O_BQKV; gN = 3072; gK = 1024; emode = 2; }
            else if (st == 5) kind = K_ATT_B;
            else if (st == 6) kind = K_DIFFFIN;
            else if (st == 7) { kind = K_GEMM_F; aoff = O_X + XB_OUTA; boff = O_BOUT; gN = 1024; gK = 1024; emode = 2; modoff = L * 3 * 9216 + 5 * 1024; }
        } else {
            if (st == 4) { kind = K_GEMM_B; aoff = O_H; boff = O_CQKV; gN = 3072; gK = 1024; emode = 1; }
            else if (st == 5) kind = K_ATT_C;
            else if (st == 6) { kind = K_GEMM_F; aoff = O_X + XB_O2; boff = O_COUT; gN = 1024; gK = 1024; emode = 2; modoff = L * 3 * 9216 + 5 * 1024; }
        }
        if (kind == K_NOP) continue;
#ifndef PROBE_DUP
#define PROBE_DUP 0
#endif
        bool dup = false;
        if ((PROBE_DUP & 1) && (kind == K_ATT_A || kind == K_ATT_B || kind == K_ATT_C)) dup = true;
        if ((PROBE_DUP & 4) && kind == K_GEMM_B && emode == 0) dup = true;
        if ((PROBE_DUP & 8) && kind == K_GEMM_B && emode != 0) dup = true;
        if ((PROBE_DUP & 16) && kind == K_ATT_A) dup = true;
        if ((PROBE_DUP & 32) && kind == K_ATT_B) dup = true;
        if ((PROBE_DUP & 128) && kind == K_NORM) dup = true;
        if (second && kind == K_NORM) pnsp = 0;

        if (kind == K_GEMM_B) {
            pg8::Gemm g{(const bf16_t*)(ws + aoff), (const bf16_t*)(ws + boff), MROWS, gN, gK}; pg8::StaticOrder SO; SO.init(MROWS, gN, gK, G, bid); pg8::EpiB eb{emode, ws};
#ifndef DIS_GEMMB
            pg8::gemm_phase<pg8::EpiB, pg8::StaticOrder, true, true>(lds, g, SO, eb);
#endif
        } else if (kind == K_GEMM_F) {
            pg8::Gemm g{(const bf16_t*)(ws + aoff), (const bf16_t*)(ws + boff), MROWS, gN, gK}; pg8::SplitOrder SO; SO.init(gN, gK, G, bid, emode != 1, !(L == DEPTH - 1 && st >= 9));   pg8::EpiF ef{emode, ws, modoff};
#ifndef DIS_GEMMF
            pg8::gemm_phase<pg8::EpiF, pg8::SplitOrder, true, true>(lds, g, SO, ef);
#endif
        } else if (kind == K_NORM) {
            const float* gv = args.in[I_NORMG] + (size_t)(L * 3 + nslot) * 1024;
            for (int row = gw; row < MROWS; row += NGW) {
                const int b = row / TPB, j = row - b * TPB, mi = j < CTXL ? 2 : b;
                const float* sh = modL + (size_t)mi * 9216 + (nslot * 3) * 1024; const float* scl = sh + 1024;
                const bool first = (ph == 0);
                const float* srcrow = first ? (j < CTXL ? args.in[I_CTX] + (size_t)(b * CTXL + j) * 1024 : args.in[I_X] + (size_t)(b * SEQ + j - CTXL) * 1024) : S + (size_t)row * 1024;
                const f32x4* xr = (const f32x4*)srcrow + lane;
                f32x4 v[4]; float ss = 0.f;
#pragma unroll
                for (int q = 0; q < 4; ++q) v[q] = xr[64 * q];
                if (first) { f32x4* xw0 = (f32x4*)(S + (size_t)row * 1024) + lane;
#pragma unroll
                    for (int q = 0; q < 4; ++q) xw0[64 * q] = v[q]; }
                if (pnsp > 0 && j < CTXL) {
                    const f32x4* pp = (const f32x4*)((const float*)(ws + O_P) + (size_t)(b * 256 + j) * 1024) + lane;
                    const f32x4* gm = (const f32x4*)(MOD + pmodoff + 2 * 9216) + lane;
                    f32x4 a4[4];
#pragma unroll
                    for (int q = 0; q < 4; ++q) a4[q] = (f32x4){0.f, 0.f, 0.f, 0.f};
                    for (int ks = 0; ks < pnsp; ++ks) {
#pragma unroll
                        for (int q = 0; q < 4; ++q) a4[q] += pp[(size_t)ks * 512 * 256 + 64 * q];
                    }
                    f32x4* xw = (f32x4*)(S + (size_t)row * 1024) + lane;
#pragma unroll
                    for (int q = 0; q < 4; ++q) { v[q] += (gm[64 * q] * pcoef) * a4[q]; xw[64 * q] = v[q]; }
                }
#pragma unroll
                for (int q = 0; q < 4; ++q) ss += (v[q].x * v[q].x + v[q].y * v[q].y) + (v[q].z * v[q].z + v[q].w * v[q].w);
                const float rstd = rsqrtf(wave_sum(ss) * (1.f / 1024.f) + RMS_EPS);
                unsigned long long* o8 = (unsigned long long*)(H + (size_t)row * 1024) + lane;
#pragma unroll
                for (int q = 0; q < 4; ++q) {
                    const f32x4 g4 = ((const f32x4*)gv)[lane + 64 * q], s4 = ((const f32x4*)scl)[lane + 64 * q], h4 = ((const f32x4*)sh)[lane + 64 * q];
                    const f32x4 y = (v[q] * rstd) * g4 * (1.0f + s4) + h4;
                    o8[64 * q] = (unsigned long long)pk2(y.x, y.y) | ((unsigned long long)pk2(y.z, y.w) << 32);
                }
            }
        } else if (kind == K_MLAMID) {
            const float* CIN = (const float*)(X + XA_CIN); bf16_t* CQN = (bf16_t*)(X + XA_CQN); bf16_t* CKVN = (bf16_t*)(X + XA_CKVN); bf16_t* Kb = (bf16_t*)(X + XA_K);
            const float* gq = args.in[I_AQN] + mj * 256; const float* gkv = args.in[I_AKVN] + mj * 128;
            for (int row = gw; row < MROWS; row += NGW) {
                const int b = row / TPB, j = row - b * TPB;
                const f32x4* cr = (const f32x4*)(CIN + (size_t)row * 512 + 8 * lane);
                const f32x4 a = cr[0], c = cr[1];
                float ss = (a.x * a.x + a.y * a.y) + (a.z * a.z + a.w * a.w) + (c.x * c.x + c.y * c.y) + (c.z * c.z + c.w * c.w);
                ss += __shfl_xor(ss, 1); ss += __shfl_xor(ss, 2); ss += __shfl_xor(ss, 4); ss += __shfl_xor(ss, 8);
                const float s32 = ss + __shfl_xor(ss, 16);
                f32x4 pa, pc;
#pragma unroll
                for (int e = 0; e < 4; ++e) { pa[e] = __shfl_xor(a[e], 4); pc[e] = __shfl_xor(c[e], 4); }
                if (lane < 32) {
                    const float rstd = rsqrtf(s32 * (1.f / 256.f) + RMS_EPS);
                    const f32x4 g0 = *(const f32x4*)(gq + 8 * lane), g1 = *(const f32x4*)(gq + 8 * lane + 4);
                    const f32x4 y0 = a * rstd * g0, y1 = c * rstd * g1;
                    u32x4 w; w.x = pk2(y0.x, y0.y); w.y = pk2(y0.z, y0.w); w.z = pk2(y1.x, y1.y); w.w = pk2(y1.z, y1.w);
                    *(u32x4*)(CQN + (size_t)row * 256 + 8 * lane) = w;
                } else if (lane < 48) {
                    const float rstd = rsqrtf(ss * (1.f / 128.f) + RMS_EPS); const int l2 = lane - 32;
                    const f32x4 g0 = *(const f32x4*)(gkv + 8 * l2), g1 = *(const f32x4*)(gkv + 8 * l2 + 4);
                    const f32x4 y0 = a * rstd * g0, y1 = c * rstd * g1;
                    u32x4 w; w.x = pk2(y0.x, y0.y); w.y = pk2(y0.z, y0.w); w.z = pk2(y1.x, y1.y); w.w = pk2(y1.z, y1.w);
                    *(u32x4*)(CKVN + (size_t)row * 128 + 8 * l2) = w;
                } else if (lane < 56) {
                    const int l3 = lane - 48; const bool second = l3 >= 4; const int jb = 8 * (l3 & 3);
                    f32x4 y0 = a, y1 = c;
                    if (j >= CTXL) {
                        const int t = j - CTXL; const int pos = (jb < 16) ? (t >> 6) : (t & 63); const float* cp = ROPE + pos * 16 + (jb & 15);
                        const f32x4 c0 = *(const f32x4*)cp, c1 = *(const f32x4*)(cp + 4), s0 = *(const f32x4*)(cp + 2048), s1 = *(const f32x4*)(cp + 2052);
                        if (!second) { y0 = a * c0 - pa * s0; y1 = c * c1 - pc * s1; }
                        else { y0 = pa * s0 + a * c0; y1 = pc * s1 + c * c1; }
                    }
                    const pg8::u32x2e w = pg8::pack8_fp8(y0, y1);
                    unsigned char* kp = (unsigned char*)Kb + (size_t)row * 1536 + 128 + 8 * l3;
#pragma unroll
                    for (int h = 0; h < 8; ++h) *(pg8::u32x2e*)(kp + h * 192) = w;
                }
            }
        } else if (kind == K_ATT_A) {
            const bf16_t* Q = (const bf16_t*)(X + XA_Q); const bf16_t* Kb = (const bf16_t*)(X + XA_K); const bf16_t* Vb = (const bf16_t*)(X + XA_V); bf16_t* O = (bf16_t*)(X + XA_O);
            const float scale = 0.07216878364870322f;
            const int nun = 512 + ((L < DEPTH - 1) ? 16 : 0);
            for (int v = vcu; v < nun; v += G) {
                int b, h, qb, nt;
                if (v < 512) { const int xcd = v & 7, cu = (v >> 3) & 31, pair = xcd + 8 * (v >> 8); b = pair >> 3; h = pair & 7; qb = 1 + cu; nt = 132; }
                else { const int u = v - 512; b = u >> 3; h = u & 7; qb = 0; nt = 4; }
                const size_t rowq = (size_t)b * TPB + 256 * qb;
#ifndef DIS_ATTA
                att::attn_unit_f8s((const unsigned char*)Q + rowq * 1536 + h * 192, (const unsigned char*)Kb + (size_t)b * TPB * 1536 + h * 192, (const unsigned char*)Vb + (size_t)((b * 8 + h) * 132) * 8192,
                                    O + rowq * 1024 + h * 128, 1024, nt, scale, (char*)lds_raw, lds);
#endif
            }
        } else if (kind == K_ATT_B) {
            const bf16_t* Q = (const bf16_t*)(X + XB_Q); const bf16_t* Kb = (const bf16_t*)(X + XB_K); const bf16_t* Vb = (const bf16_t*)(X + XB_V); bf16_t* O = (bf16_t*)(X + XB_O2);
            for (int v = vcu; v < 1024 + 32; v += G) {
                int b, hq, qb, nt;
                if (v < 1024) { const int xcd = v & 7, cu = (v >> 3) & 31, pair = xcd + 8 * (v >> 8); b = pair >> 4; hq = pair & 15; qb = 1 + cu; nt = 132; }
                else { const int u = v - 1024; b = u >> 4; hq = u & 15; qb = 0; nt = 4; }
                const size_t rowq = (size_t)b * TPB + 256 * qb;
#ifndef DIS_ATTB
                att::attn_unit<64, 128, 0, false>(Q + rowq * 1024 + hq * 64, 1024, Kb + (size_t)b * TPB * 1024 + hq * 64, 1024, Vb + (size_t)b * TPB * 1024 + (hq >> 1) * 128, 1024,
                                                  O + rowq * 2048 + hq * 128, 2048, nt, 0, 0.125f, 0, 0, (char*)lds_raw, lds);
#endif
            }
        } else if (kind == K_ATT_C) {
            const bf16_t* Q = (const bf16_t*)(X + XB_Q); const bf16_t* Kb = (const bf16_t*)(X + XB_K); const bf16_t* Vb = (const bf16_t*)(X + XB_V); bf16_t* O = (bf16_t*)(X + XB_O2);
            float* btab = (float*)(lds_raw + 98304);
            for (int v = vcu; v < 1024 + 32; v += G) {
                int b, h, qb, nt, r0 = 0, krlo = 0;
                if (v < 1024) { const int xcd = v & 7, cu = (v >> 3) & 31, pair = xcd + 8 * (v >> 8); b = pair >> 4; h = pair & 15; qb = 1 + cu; nt = 15; r0 = 4 * cu; krlo = min(max(r0 - 4, 0), 117); }
                else { const int u = v - 1024; b = u >> 4; h = u & 15; qb = 0; nt = 4; }
                for (int i = tid; i < 465; i += 512) btab[i] = args.in[I_CRPB][h * 465 + i] * 8.0f;
                const size_t rowq = (size_t)b * TPB + 256 * qb;
#ifndef DIS_ATTC
                att::attn_unit<64, 64, 0, true>(Q + rowq * 1024 + h * 64, 1024, Kb + (size_t)b * TPB * 1024 + h * 64, 1024, Vb + (size_t)b * TPB * 1024 + h * 64, 1024,
                                                O + rowq * 1024 + h * 64, 1024, nt, 64 * krlo, 0.125f, r0, krlo, (char*)lds_raw, lds);
#endif
            }
        } else if (kind == K_DIFFFIN) {
            const bf16_t* O2 = (const bf16_t*)(X + XB_O2); bf16_t* OA = (bf16_t*)(X + XB_OUTA);
            const float lam_init = 0.8f - 0.6f * 0.7408182206817179f;
            const float d1 = wave_sum(args.in[I_BLQ1][lane] * args.in[I_BLK1][lane]), d2 = wave_sum(args.in[I_BLQ2][lane] * args.in[I_BLK2][lane]);
            const float lam = expf(d1) - expf(d2) + lam_init;
            const float g0 = args.in[I_BSUB][2 * lane] * (1.f - lam_init), g1 = args.in[I_BSUB][2 * lane + 1] * (1.f - lam_init);
            for (int row = gw; row < MROWS; row += NGW) {
                const unsigned* orow = (const unsigned*)(O2 + (size_t)row * 2048);
                unsigned* dst = (unsigned*)(OA + (size_t)row * 1024);
#pragma unroll
                for (int h = 0; h < 8; ++h) {
                    const unsigned w0 = orow[(2 * h) * 64 + lane], w1 = orow[(2 * h + 1) * 64 + lane];
                    const float x0 = bf2f((unsigned short)(w0 & 0xffff)) - lam * bf2f((unsigned short)(w1 & 0xffff));
                    const float x1 = bf2f((unsigned short)(w0 >> 16)) - lam * bf2f((unsigned short)(w1 >> 16));
                    const float rstd = rsqrtf(wave_sum(x0 * x0 + x1 * x1) * (1.f / 128.f) + RMS_EPS);
                    dst[h * 64 + lane] = pk2(x0 * rstd * g0, x1 * rstd * g1);
                }
            }
        } else if (kind == K_FINAL) {
            const float* gv = args.in[I_FING];
            for (int r = gw; r < NBATCH * SEQ; r += NGW) {
                const int b = r / SEQ, t = r - b * SEQ; const size_t row = (size_t)b * TPB + CTXL + t;
                const f32x4* xr = (const f32x4*)(S + row * 1024) + lane;
                f32x4 v[4]; float ss = 0.f;
#pragma unroll
                for (int q = 0; q < 4; ++q) { v[q] = xr[64 * q]; ss += (v[q].x * v[q].x + v[q].y * v[q].y) + (v[q].z * v[q].z + v[q].w * v[q].w); }
                const float rstd = rsqrtf(wave_sum(ss) * (1.f / 1024.f) + RMS_EPS);
                f32x4* o4 = (f32x4*)(args.out + (size_t)r * 1024) + lane;
#pragma unroll
                for (int q = 0; q < 4; ++q) o4[64 * q] = (v[q] * rstd) * ((const f32x4*)gv)[lane + 64 * q];
            }
        }
        if (st == 4 && L < DEPTH - 1 && (kind == K_GEMM_B || kind == K_GEMM_F)) {
            const int nwg_ = 66 * (gN / 256), rem_ = nwg_ % G, nid_ = rem_ ? G - rem_ : G, rank_ = rem_ ? bid - rem_ : bid;
            if (rank_ >= 0) {
                const int Ln = L + 1, blen_ = (Ln == 3) ? 1088 : 2048, b0_ = (Ln == 1) ? 35968 : (Ln == 2 ? 38016 : 34880);
                prep_weights(args, (LAS float*)(lds + wave * 16384), rank_ * 8 + wave, nid_ * 8, lane, Ln * 8448, 8448, b0_, 0, 8448 + blen_);
            }
        }
        if (sync_after && kind != K_FINAL) { xcd_barrier(xbar); if (PROBE_DUP & 2) xcd_barrier(xbar); }
        if (PROBE_DUP != 0) { if (dup && !second) { second = true; --ph; } else second = false; }
    }
}

extern "C" void kernel_launch(void* const* d_in, const int* in_sizes, int n_in, void* d_out, int out_size, void* d_ws, size_t ws_size, hipStream_t stream) {
    static int grid_blocks = 0;
    if (grid_blocks == 0) {
        if (n_in != 27 || ws_size < WS_NEED) { fprintf(stderr, "kernel_launch: n_in %d (want 27), ws %zu (need %zu)\n", n_in, ws_size, (size_t)WS_NEED); grid_blocks = -1; return; }
        int dev = 0, cus = 0, per_cu = 0;
        hipGetDevice(&dev);
        hipDeviceGetAttribute(&cus, hipDeviceAttributeMultiprocessorCount, dev);
        if (hipFuncSetAttribute((const void*)fwd_mega, hipFuncAttributeMaxDynamicSharedMemorySize, LDS_BYTES) != hipSuccess) { fprintf(stderr, "kernel_launch: hipFuncSetAttribute failed\n"); grid_blocks = -1; return; }
        if (hipOccupancyMaxActiveBlocksPerMultiprocessor(&per_cu, (const void*)fwd_mega, 512, LDS_BYTES) != hipSuccess || per_cu < 1) { fprintf(stderr, "kernel_launch: occupancy query says %d\n", per_cu); per_cu = 1; (void)hipGetLastError(); }
        grid_blocks = cus;
        if (grid_blocks % 8 != 0) grid_blocks = (grid_blocks / 8) * 8;
    }
    if (grid_blocks < 0) return;
    if (hipMemsetAsync((char*)d_ws + O_CTL, 0, CTL_BYTES, stream) != hipSuccess) { fprintf(stderr, "kernel_launch: hipMemsetAsync failed\n"); return; }
    Args a{};
    for (int i = 0; i < 27; ++i) a.in[i] = (const float*)d_in[i];
    a.out = (float*)d_out; a.ws = (unsigned char*)d_ws;
    void* kargs[] = {&a};
    hipError_t e = hipLaunchCooperativeKernel((const void*)fwd_mega, dim3(grid_blocks), dim3(512), kargs, LDS_BYTES, stream);
    if (e != hipSuccess) fprintf(stderr, "cooperative launch failed: %s (grid %d)\n", hipGetErrorString(e), grid_blocks);
}
```

```cpp
#include <hip/hip_runtime.h>
#include <hip/hip_cooperative_groups.h>
#include <cstdio>
#include <cstdint>
namespace cg = cooperative_groups;

constexpr int DM = 1024, NBATCH = 2, SEQ = 8192, CTXL = 256, TPB = SEQ + CTXL  , MROWS = NBATCH * TPB  ;
constexpr int DFF = 2816, DEPTH = 4, TILES_PB = TPB / 256  ;
constexpr float RMS_EPS = 1e-6f;

constexpr size_t SZ_WGU = 5632ull * 1024 * 2, SZ_WD = 1024ull * 2816 * 2;
constexpr size_t O_WGU = 0;
constexpr size_t O_WD = O_WGU + 8 * SZ_WGU;
constexpr size_t O_AIN = O_WD + 8 * SZ_WD;
constexpr size_t O_AUQ = O_AIN + 2ull * 512 * 1024 * 2;
constexpr size_t O_AUKV = O_AUQ + 2ull * 1536 * 256 * 2;
constexpr size_t O_AOUT = O_AUKV + 2ull * 2048 * 128 * 2;
constexpr size_t O_BQKV = O_AOUT + 2ull * 1024 * 1024 * 2;
constexpr size_t O_BOUT = O_BQKV + 3072ull * 1024 * 2;
constexpr size_t O_CQKV = O_BOUT + 1024ull * 1024 * 2;
constexpr size_t O_COUT = O_CQKV + 3072ull * 1024 * 2;
constexpr size_t O_MOD = O_COUT + 1024ull * 1024 * 2;
constexpr size_t O_ROPE = O_MOD + 4ull * 3 * 9216 * 4;
constexpr size_t O_S = (O_ROPE + 2 * 2048 * 4 + 255) & ~size_t(255);
constexpr size_t O_H = O_S + (size_t)MROWS * 1024 * 4;
constexpr size_t O_X = O_H + (size_t)MROWS * 1024 * 2;
constexpr size_t SZ_M1K = (size_t)MROWS * 1024 * 2;
constexpr size_t XA_CIN = 0, XA_CQN = XA_CIN + (size_t)MROWS * 512 * 4, XA_CKVN = XA_CQN + (size_t)MROWS * 256 * 2, XA_Q = XA_CKVN + (size_t)MROWS * 128 * 2,
                 XA_K = XA_Q + (size_t)MROWS * 1536 * 2, XA_V = XA_K + (size_t)MROWS * 1536 * 2, XA_O = XA_V + SZ_M1K, XA_END = XA_O + SZ_M1K;
constexpr size_t XB_Q = 0, XB_K = SZ_M1K, XB_V = 2 * SZ_M1K, XB_O2 = 3 * SZ_M1K, XB_OUTA = XB_O2 + 2 * SZ_M1K, XB_END = XB_OUTA + SZ_M1K;
constexpr size_t O_P = O_X + (XA_END > XB_END ? XA_END : XB_END);
constexpr size_t O_CTL = O_P + 11ull * 512 * 1024 * 4;
constexpr size_t CTL_BYTES = 16384;
constexpr size_t WS_NEED = O_CTL + CTL_BYTES;

constexpr int LDS_MISC = 157696;
constexpr int LDS_BYTES = LDS_MISC + 1024;
#define LAS __attribute__((address_space(3)))
namespace pg8 {
#define PG8_LAS __attribute__((address_space(3)))
typedef unsigned short bf16_t;
typedef short bf16x8 __attribute__((ext_vector_type(8)));
typedef float f32x4 __attribute__((ext_vector_type(4)));
typedef unsigned u32x4 __attribute__((ext_vector_type(4)));
constexpr int BM = 256, BK = 64, HALF = 128, HTB = HALF * BK * 2  , STAGE_BYTES = 8 * HTB, NXCD = 8, WGM = 8;

__host__ __device__ __forceinline__ int lds_byte(int r, int c) { const int st = (r >> 4) * 2 + (c >> 5), rr = r & 15, cc = c & 31, ob = rr * 64 + cc * 2; return st * 1024 + (ob ^ (((ob >> 9) & 1) << 5)); }
__host__ __device__ __forceinline__ void stage_rc(int b, int& R, int& C) { const int st = b / 1024, sb = b % 1024, swz = sb ^ (((sb >> 9) & 1) << 5); R = (st >> 1) * 16 + swz / 64; C = (st & 1) * 32 + (swz % 64) / 2; }
__host__ __device__ __forceinline__ int perm32(int rho) { const int n = rho >> 4, i = rho & 15; return 8 * (i >> 2) + 4 * n + (i & 3); }

struct Unit { int pm, pn, k0, nk, flags; };
struct Gemm { const bf16_t* A; const bf16_t* Bt; int M, N, K; };

struct StaticOrder {
    int nM, nN, nwg, G, c, ntk;
    __host__ __device__ void init(int M, int N, int K, int G_, int c_) { nM = M / BM; nN = N / BM; nwg = nM * nN; G = G_; c = c_; ntk = K / BK; }
    __host__ __device__ bool next(int i, Unit& u) const {
        const long L = (long)i * G + c; if (L >= nwg) return false;
        int wgid = (int)L; { const int q = nwg / NXCD, r = nwg % NXCD, xcd = wgid % NXCD, off = wgid / NXCD; wgid = (xcd < r ? xcd * (q + 1) : r * (q + 1) + (xcd - r) * q) + off; }
        const int nig = WGM * nN, gid = wgid / nig, fm = gid * WGM, gsz = (nM - fm) < WGM ? (nM - fm) : WGM;
        u.pm = fm + ((wgid % nig) % gsz); u.pn = (wgid % nig) / gsz; u.k0 = 0; u.nk = ntk; u.flags = 0; return true;
    }
    __device__ __forceinline__ void a_ready(const Unit&) const {}
    __device__ __forceinline__ void done(const Unit&) const {}
};
struct SplitOrder {
    StaticOrder so; int nN, ntk, nsp, nfull, nsu, G, c; bool split;
    __device__ void init(int N, int K, int G_, int c_, bool split_, bool ctx_units) {
        split = split_; G = G_; c = c_; nN = N / BM; ntk = K / BK; nsp = ntk / 4;
        if (split) { so.init(64 * BM, N, K, G_, c_); nfull = 64 * nN; nsu = ctx_units ? 2 * nN * nsp : 0; } else { so.init(66 * BM, N, K, G_, c_); nfull = 66 * nN; nsu = 0; }
    }
    __device__ bool next(int i, Unit& u) const {
        const long L = (long)i * G + c;
        if (L < nfull) { so.next(i, u); if (split) u.pm = u.pm < 32 ? u.pm + 1 : u.pm + 2; return true; }
        const int s = (int)(L - nfull); if (s >= nsu) return false;
        const int per = nN * nsp, cb = s / per, r = s - cb * per;
        u.pm = cb * 33; u.pn = r / nsp; u.k0 = 4 * (r - u.pn * nsp); u.nk = 4; u.flags = 1; return true;
    }
    __device__ __forceinline__ void a_ready(const Unit&) const {}
    __device__ __forceinline__ void done(const Unit&) const {}
};
__device__ __forceinline__ unsigned cvt_pk_bf16(float lo, float hi) { unsigned r; asm volatile("v_cvt_pk_bf16_f32 %0, %1, %2" : "=v"(r) : "v"(lo), "v"(hi)); return r; }
__device__ __forceinline__ u32x4 pack8(const f32x4 a, const f32x4 b) { u32x4 w; w.x = cvt_pk_bf16(a[0], a[1]); w.y = cvt_pk_bf16(a[2], a[3]); w.z = cvt_pk_bf16(b[0], b[1]); w.w = cvt_pk_bf16(b[2], b[3]); return w; }
typedef unsigned u32x2e __attribute__((ext_vector_type(2)));
__device__ __forceinline__ u32x2e pack8_fp8(const f32x4 a, const f32x4 b) {
    int w0 = __builtin_amdgcn_cvt_pk_fp8_f32(a[0], a[1], 0, false); w0 = __builtin_amdgcn_cvt_pk_fp8_f32(a[2], a[3], w0, true);
    int w1 = __builtin_amdgcn_cvt_pk_fp8_f32(b[0], b[1], 0, false); w1 = __builtin_amdgcn_cvt_pk_fp8_f32(b[2], b[3], w1, true);
    u32x2e r; r.x = (unsigned)w0; r.y = (unsigned)w1; return r;
}
__device__ __forceinline__ float silu_f(float g) { return g * __builtin_amdgcn_rcpf(1.0f + __builtin_amdgcn_exp2f(-1.4426950408889634f * g)); }

struct EpiB {
    static constexpr bool PERM = true, AFTER_DRAIN = false;
    int mode; unsigned char* ws;
    __device__ __forceinline__ void operator()(const f32x4 (&acc)[2][2][4][2], const Unit& u, int wr, int wc, int fr, int fq) const {
        const int row0 = u.pm * BM + wr * 64 + fr;
        const int o8 = wc * 32 + 8 * fq;
        unsigned char* const X = ws + O_X;
        bf16_t* const o0 = (bf16_t*)(X + (mode == 3 ? XA_K : (mode == 4 ? XA_Q : 0)));
        bf16_t* const o1 = (bf16_t*)(X + (mode == 3 ? XA_V : XB_K));
        bf16_t* const o2 = (bf16_t*)(X + XB_V);
        const float* const rope = (const float*)(ws + O_ROPE);
        if (mode == 0) {
#pragma unroll
            for (int ai = 0; ai < 2; ++ai)
#pragma unroll
                for (int m = 0; m < 4; ++m) {
                    const size_t r = (size_t)(row0 + ai * HALF + m * 16);
                    f32x4 v0, v1;
#pragma unroll
                    for (int i = 0; i < 4; ++i) { v0[i] = silu_f(acc[ai][0][m][0][i]) * acc[ai][1][m][0][i]; v1[i] = silu_f(acc[ai][0][m][1][i]) * acc[ai][1][m][1][i]; }
                    *(u32x4*)(o0 + r * 2816 + u.pn * 128 + o8) = pack8(v0, v1);
                    if (m & 1) asm volatile("" ::: "memory");
                }
            return;
        }
        const bool ropet = (mode == 2 && u.pn < 8) || (mode == 4 && u.pn >= 4);
        if (!ropet) {
#pragma unroll
            for (int bj = 0; bj < 2; ++bj) {
                bf16_t* base; size_t ld; int col;
                if ((mode == 3 && bj == 0) || mode == 4) {
                    unsigned char* b8 = (unsigned char*)o0; const int colb = (mode == 3) ? (u.pn * 192 + o8) : ((2 * u.pn + bj) * 192 + o8);
#pragma unroll
                    for (int ai = 0; ai < 2; ++ai)
#pragma unroll
                        for (int m = 0; m < 4; ++m) {
                            const size_t r = (size_t)(row0 + ai * HALF + m * 16);
                            *(u32x2e*)(b8 + r * 1536 + colb) = pack8_fp8(acc[ai][bj][m][0], acc[ai][bj][m][1]);
                        }
                    continue;
                }
                if (mode == 3) {
                    unsigned char* v8 = (unsigned char*)o1; const int bb3 = u.pm / 33;
#pragma unroll
                    for (int ai = 0; ai < 2; ++ai)
#pragma unroll
                        for (int m = 0; m < 4; ++m) {
                            const int key = row0 + ai * HALF + m * 16 - bb3 * TPB;
                            const int k6 = key & 63, kp = 32 * ((k6 >> 2) & 1) + 4 * (k6 >> 3) + (k6 & 3);
                            unsigned char* tp = v8 + ((size_t)((bb3 * 8 + u.pn) * 132 + (key >> 6)) * 8192) + (size_t)o8 * 64 + kp;
                            const u32x2e w = pack8_fp8(acc[ai][1][m][0], acc[ai][1][m][1]);
#pragma unroll
                            for (int e = 0; e < 4; ++e) { tp[e * 64] = (unsigned char)(w.x >> (8 * e)); tp[(4 + e) * 64] = (unsigned char)(w.y >> (8 * e)); }
                        }
                    continue;
                }
                else { const int gcol = u.pn * 256 + bj * 128 + o8; const int buf = gcol >> 10; base = buf == 0 ? o0 : (buf == 1 ? o1 : o2); ld = 1024; col = gcol & 1023; }
#pragma unroll
                for (int ai = 0; ai < 2; ++ai)
#pragma unroll
                    for (int m = 0; m < 4; ++m) {
                        const size_t r = (size_t)(row0 + ai * HALF + m * 16);
                        *(u32x4*)(base + r * ld + col) = pack8(acc[ai][bj][m][0], acc[ai][bj][m][1]);
                    }
            }
            return;
        }
        {
            bf16_t* base; size_t ld; int col1;
            if (mode == 2) { base = (u.pn < 4) ? o0 : o1; ld = 1024; col1 = (u.pn & 3) * 256 + 64 * wc + 8 * fq; }
            else { base = o0; ld = 1536; col1 = (4 * (u.pn - 4) + wc) * 192 + 128 + 8 * fq; }
            const int bb = u.pm / 33; const bool lat = (u.pm - bb * 33) != 0;
#pragma unroll
            for (int ai = 0; ai < 2; ++ai)
#pragma unroll
                for (int m = 0; m < 4; ++m) {
                    const int ri = row0 + ai * HALF + m * 16; const size_t r = (size_t)ri;
                    f32x4 y1a = acc[ai][0][m][0], y1b = acc[ai][0][m][1], y2a = acc[ai][1][m][0], y2b = acc[ai][1][m][1];
                    if (lat) {
                        const int t = ri - bb * TPB - CTXL; const int pos = (fq < 2) ? (t >> 6) : (t & 63);
                        const float* cp = rope + pos * 16 + 8 * (fq & 1);
                        const f32x4 c0 = *(const f32x4*)cp, c1 = *(const f32x4*)(cp + 4), s0 = *(const f32x4*)(cp + 2048), s1 = *(const f32x4*)(cp + 2052);
                        const f32x4 x1a = y1a, x1b = y1b, x2a = y2a, x2b = y2b;
                        y1a = x1a * c0 - x2a * s0; y1b = x1b * c1 - x2b * s1;
                        y2a = x1a * s0 + x2a * c0; y2b = x1b * s1 + x2b * c1;
                    }
                    if (mode == 4) { unsigned char* b8 = (unsigned char*)o0;
                        *(u32x2e*)(b8 + r * 1536 + col1) = pack8_fp8(y1a, y1b); *(u32x2e*)(b8 + r * 1536 + col1 + 32) = pack8_fp8(y2a, y2b); }
                    else { *(u32x4*)(base + r * ld + col1) = pack8(y1a, y1b);
                    *(u32x4*)(base + r * ld + col1 + 32) = pack8(y2a, y2b); }
                    asm volatile("" ::: "memory");
                }
        }
    }
};

struct EpiF {
    static constexpr bool PERM = false, AFTER_DRAIN = false;
    int mode; unsigned char* ws; int modoff;
    __device__ __forceinline__ void operator()(const f32x4 (&acc)[2][2][4][2], const Unit& u, int wr, int wc, int fr, int fq) const {
        float* const out = (float*)(ws + (mode == 1 ? (O_X + XA_CIN) : O_S)); const int ld = 512;
        const float* const modg = (const float*)(ws + O_MOD) + modoff; const float coef = mode == 0 ? 0.5f : 1.0f;
        const int row0 = u.pm * BM + wr * 64 + fr; const int col0 = u.pn * BM + wc * 32 + 4 * fq;
        if (u.flags & 1) {
            float* P = (float*)(ws + O_P) + ((size_t)(u.k0 >> 2) * 512 + (u.pm ? 256 : 0) + wr * 64 + fr) * 1024 + col0;
#pragma unroll
            for (int ai = 0; ai < 2; ++ai)
#pragma unroll
                for (int m = 0; m < 4; ++m) {
                    float* rp = P + (size_t)(ai * HALF + m * 16) * 1024;
#pragma unroll
                    for (int bj = 0; bj < 2; ++bj)
#pragma unroll
                        for (int n = 0; n < 2; ++n) *(f32x4*)(rp + bj * HALF + n * 16) = acc[ai][bj][m][n];
                }
            return;
        }
        if (mode != 1) {
            const int bb = u.pm / 33; const int mi = ((u.pm - bb * 33) == 0) ? 2 : bb;
            f32x4 gv[2][2];
#pragma unroll
            for (int bj = 0; bj < 2; ++bj)
#pragma unroll
                for (int n = 0; n < 2; ++n) gv[bj][n] = *(const f32x4*)(modg + mi * 9216 + col0 + bj * HALF + n * 16) * coef;
#pragma unroll
            for (int ai = 0; ai < 2; ++ai)
#pragma unroll
                for (int m = 0; m < 4; ++m) {
                    float* rp = out + (size_t)(row0 + ai * HALF + m * 16) * 1024 + col0;
#pragma unroll
                    for (int bj = 0; bj < 2; ++bj)
#pragma unroll
                        for (int n = 0; n < 2; ++n) { f32x4* p = (f32x4*)(rp + bj * HALF + n * 16); *p = *p + gv[bj][n] * acc[ai][bj][m][n]; }
                    asm volatile("" ::: "memory");
                }
        } else {
#pragma unroll
            for (int ai = 0; ai < 2; ++ai)
#pragma unroll
                for (int m = 0; m < 4; ++m) {
                    float* rp = out + (size_t)(row0 + ai * HALF + m * 16) * ld + col0;
#pragma unroll
                    for (int bj = 0; bj < 2; ++bj)
#pragma unroll
                        for (int n = 0; n < 2; ++n) *(f32x4*)(rp + bj * HALF + n * 16) = acc[ai][bj][m][n];
                }
        }
    }
};

template <class Epi, class Sched, bool ALIGN_EPI = false, bool SP2 = false>
__device__ __forceinline__ void gemm_phase(PG8_LAS unsigned char* lds, const Gemm g, const Sched& S, const Epi& E) {
    int tid_ = threadIdx.x; asm volatile("" : "+v"(tid_));
    const int tid = tid_, wid = __builtin_amdgcn_readfirstlane(tid >> 6), lane = tid & 63, wr = wid >> 2, wc = wid & 3, fr = lane & 15, fq = lane >> 4;
    const int K = g.K;
    unsigned voffA[2], voffB[2];
#pragma unroll
    for (int i = 0; i < 2; ++i) { int R, C; stage_rc(tid * 16 + i * 8192, R, C); const int Rb = Epi::PERM ? ((R & ~31) + perm32(R & 31)) : R;
        voffA[i] = (unsigned)(R * K + C) * 2u; voffB[i] = (unsigned)(Rb * K + C) * 2u; }
    const size_t kstep = (size_t)(BK * 2);
    const size_t hstep = (size_t)HALF * K * 2;
    const size_t tstep = 2 * hstep;
    const unsigned ldsw = (unsigned)wid * 1024u;
    const int aoff = lds_byte(wr * 64 + fr, fq * 8), boff = lds_byte(wc * 32 + fr, fq * 8);
#define PG8_SA(b, h) (((b) * 2 + (h)) * HTB)
#define PG8_SB(b, h) ((4 + (b) * 2 + (h)) * HTB)
#define PG8_STAGE(bufoff, gbase, voff) do { _Pragma("unroll") for (int _i = 0; _i < 2; ++_i) \
        __builtin_amdgcn_global_load_lds((const unsigned*)((const char*)(gbase) + (voff)[_i]), (PG8_LAS unsigned*)(lds + (bufoff) + ldsw + _i * 8192), 16, 0, 0); } while (0)
#define PG8_LDA(dst, b, h) do { _Pragma("unroll") for (int m = 0; m < 4; ++m) _Pragma("unroll") for (int k = 0; k < 2; ++k) dst[m][k] = *(const PG8_LAS bf16x8*)(lds + PG8_SA(b, h) + aoff + m * 2048 + k * 1024); } while (0)
#define PG8_LDB(dst, b, h) do { _Pragma("unroll") for (int n = 0; n < 2; ++n) _Pragma("unroll") for (int k = 0; k < 2; ++k) dst[n][k] = *(const PG8_LAS bf16x8*)(lds + PG8_SB(b, h) + boff + n * 2048 + k * 1024); } while (0)
#define PG8_MMA(ai, bj, At, Bt) do { __builtin_amdgcn_s_setprio(1); _Pragma("unroll") for (int m = 0; m < 4; ++m) _Pragma("unroll") for (int n = 0; n < 2; ++n) _Pragma("unroll") for (int k = 0; k < 2; ++k) \
        acc[ai][bj][m][n] = __builtin_amdgcn_mfma_f32_16x16x32_bf16(Bt[n][k], At[m][k], acc[ai][bj][m][n], 0, 0, 0); __builtin_amdgcn_s_setprio(0); } while (0)
#define PG8_WAIT_V(n) asm volatile("s_waitcnt vmcnt(" #n ")" ::: "memory")
#define PG8_WAIT_L(n) asm volatile("s_waitcnt lgkmcnt(" #n ")" ::: "memory")
#define PG8_BAR __builtin_amdgcn_s_barrier()
#define PG8_SCHED __builtin_amdgcn_sched_barrier(0)
    Unit cur, nxt; int ui = 0;
    if (!S.next(0, cur)) return;
    f32x4 acc[2][2][4][2];
#pragma unroll
    for (int a = 0; a < 2; ++a)
#pragma unroll
        for (int b = 0; b < 2; ++b)
#pragma unroll
            for (int m = 0; m < 4; ++m)
#pragma unroll
                for (int n = 0; n < 2; ++n) acc[a][b][m][n] = (f32x4){0.f, 0.f, 0.f, 0.f};
    bf16x8 At[4][2], B0[2][2], B1[2][2];
    const char* cA = (const char*)g.A + (size_t)cur.pm * tstep + (size_t)cur.k0 * kstep; const char* cB = (const char*)g.Bt + (size_t)cur.pn * tstep + (size_t)cur.k0 * kstep; int nt = cur.nk;
    S.a_ready(cur);
    if constexpr (SP2) {
        PG8_STAGE(PG8_SB(0, 0), cB, voffB); PG8_STAGE(PG8_SB(0, 1), cB + hstep, voffB); PG8_STAGE(PG8_SA(0, 0), cA, voffA); PG8_STAGE(PG8_SA(0, 1), cA + hstep, voffA);
        if (wr == 1) PG8_BAR;
        PG8_WAIT_V(2); PG8_BAR;
        PG8_STAGE(PG8_SB(1, 0), cB + kstep, voffB); PG8_STAGE(PG8_SA(1, 0), cA + kstep, voffA); PG8_STAGE(PG8_SB(1, 1), cB + hstep + kstep, voffB);
        PG8_WAIT_V(6); PG8_BAR;
    } else {
        PG8_STAGE(PG8_SB(0, 0), cB, voffB); PG8_STAGE(PG8_SA(0, 0), cA, voffA); PG8_STAGE(PG8_SB(0, 1), cB + hstep, voffB); PG8_STAGE(PG8_SA(0, 1), cA + hstep, voffA);
        if (wr == 1) PG8_BAR;
        PG8_WAIT_V(4); PG8_BAR;
        PG8_STAGE(PG8_SB(1, 0), cB + kstep, voffB); PG8_STAGE(PG8_SA(1, 0), cA + kstep, voffA); PG8_STAGE(PG8_SB(1, 1), cB + hstep + kstep, voffB);
        PG8_WAIT_V(6); PG8_BAR;
    }
    for (;;) {
        const bool has_next = S.next(ui + 1, nxt);
        const char* nA = has_next ? (const char*)g.A + (size_t)nxt.pm * tstep + (size_t)nxt.k0 * kstep : cA; const char* nB = has_next ? (const char*)g.Bt + (size_t)nxt.pn * tstep + (size_t)nxt.k0 * kstep : cB;
        for (int t = 0; t < nt; t += 2) {
            const bool last = (t == nt - 2);
            const char* a1 = cA + (size_t)(t + 1) * kstep;
            const char* a2 = last ? nA : cA + (size_t)(t + 2) * kstep; const char* b2 = last ? nB : cB + (size_t)(t + 2) * kstep;
            const char* a3 = a2 + kstep; const char* b3 = b2 + kstep;
            if (last && has_next) S.a_ready(nxt);
            if constexpr (SP2) {
            PG8_LDB(B0, 0, 0); PG8_LDB(B1, 0, 1); PG8_SCHED; PG8_LDA(At, 0, 0); PG8_STAGE(PG8_SA(1, 1), a1 + hstep, voffA);
            PG8_WAIT_V(8); PG8_WAIT_L(0); PG8_BAR; PG8_MMA(0, 0, At, B0); PG8_MMA(0, 1, At, B1); PG8_BAR; PG8_SCHED;
            PG8_LDA(At, 0, 1); PG8_STAGE(PG8_SB(0, 0), b2, voffB); PG8_STAGE(PG8_SB(0, 1), b2 + hstep, voffB); PG8_STAGE(PG8_SA(0, 0), a2, voffA);
            PG8_WAIT_V(8); PG8_WAIT_L(0); PG8_BAR; PG8_MMA(1, 0, At, B0); PG8_MMA(1, 1, At, B1); PG8_BAR; PG8_SCHED;
            PG8_LDB(B0, 1, 0); PG8_LDB(B1, 1, 1); PG8_SCHED; PG8_LDA(At, 1, 0); PG8_STAGE(PG8_SA(0, 1), a2 + hstep, voffA);
            PG8_WAIT_V(8); PG8_WAIT_L(0); PG8_BAR; PG8_MMA(0, 0, At, B0); PG8_MMA(0, 1, At, B1); PG8_BAR; PG8_SCHED;
            PG8_LDA(At, 1, 1); PG8_STAGE(PG8_SB(1, 0), b3, voffB); PG8_STAGE(PG8_SB(1, 1), b3 + hstep, voffB); PG8_STAGE(PG8_SA(1, 0), a3, voffA);
            PG8_WAIT_V(8); PG8_WAIT_L(0); PG8_BAR; PG8_MMA(1, 0, At, B0); PG8_MMA(1, 1, At, B1); PG8_BAR; PG8_SCHED;
            } else {
            PG8_LDB(B0, 0, 0); PG8_SCHED; PG8_LDA(At, 0, 0); PG8_STAGE(PG8_SA(1, 1), a1 + hstep, voffA);
            PG8_WAIT_L(8); PG8_BAR; PG8_WAIT_L(0); PG8_MMA(0, 0, At, B0); PG8_BAR; PG8_SCHED;
            PG8_LDB(B1, 0, 1); PG8_STAGE(PG8_SB(0, 0), b2, voffB);
            PG8_BAR; PG8_WAIT_L(0); PG8_MMA(0, 1, At, B1); PG8_BAR;
            PG8_LDA(At, 0, 1); PG8_STAGE(PG8_SA(0, 0), a2, voffA);
            PG8_BAR; PG8_WAIT_L(0); PG8_MMA(1, 0, At, B0); PG8_BAR; PG8_SCHED;
            PG8_STAGE(PG8_SB(0, 1), b2 + hstep, voffB);
            PG8_WAIT_V(6); PG8_BAR; PG8_MMA(1, 1, At, B1); PG8_BAR;
            PG8_LDB(B0, 1, 0); PG8_SCHED; PG8_LDA(At, 1, 0); PG8_STAGE(PG8_SA(0, 1), a2 + hstep, voffA);
            PG8_WAIT_L(8); PG8_BAR; PG8_WAIT_L(0); PG8_MMA(0, 0, At, B0); PG8_BAR; PG8_SCHED;
            PG8_LDB(B1, 1, 1); PG8_STAGE(PG8_SB(1, 0), b3, voffB);
            PG8_BAR; PG8_WAIT_L(0); PG8_MMA(0, 1, At, B1); PG8_BAR;
            PG8_LDA(At, 1, 1); PG8_STAGE(PG8_SA(1, 0), a3, voffA);
            PG8_BAR; PG8_WAIT_L(0); PG8_MMA(1, 0, At, B0); PG8_BAR; PG8_SCHED;
            PG8_STAGE(PG8_SB(1, 1), b3 + hstep, voffB);
            PG8_WAIT_V(6); PG8_BAR; PG8_MMA(1, 1, At, B1); PG8_BAR;
            }
        }
        if constexpr (ALIGN_EPI) { if (wr == 0) PG8_BAR; }
        if constexpr (!Epi::AFTER_DRAIN) { E(acc, cur, wr, wc, fr, fq); S.done(cur); }
        if (!has_next) break;
#pragma unroll
        for (int a = 0; a < 2; ++a)
#pragma unroll
            for (int b = 0; b < 2; ++b)
#pragma unroll
                for (int m = 0; m < 4; ++m)
#pragma unroll
                    for (int n = 0; n < 2; ++n) acc[a][b][m][n] = (f32x4){0.f, 0.f, 0.f, 0.f};
        cur = nxt; cA = nA; cB = nB; ++ui; nt = cur.nk;
        if constexpr (ALIGN_EPI) { if (wr == 1) PG8_BAR; }
    }
    PG8_WAIT_V(0);
    if constexpr (!ALIGN_EPI) { if (wr == 0) PG8_BAR; }
    PG8_BAR;
    if constexpr (Epi::AFTER_DRAIN) { E.fused(acc, cur, wr, wc, fr, fq, lds, wid, lane); S.done(cur); }
#undef PG8_SA
#undef PG8_SB
#undef PG8_STAGE
#undef PG8_LDA
#undef PG8_LDB
#undef PG8_MMA
#undef PG8_WAIT_V
#undef PG8_WAIT_L
#undef PG8_BAR
#undef PG8_SCHED
}
}
namespace att {
typedef unsigned short bf16_t;
using bf16x8 = __attribute__((ext_vector_type(8))) short;
using s16x4  = __attribute__((ext_vector_type(4))) short;
using f32x16 = __attribute__((ext_vector_type(16))) float;
using u32x4  = __attribute__((ext_vector_type(4))) unsigned;
#define SBAR() __builtin_amdgcn_sched_barrier(0)
__device__ __forceinline__ int crow(int r, int hi) { return (r & 3) + 8 * (r >> 2) + 4 * hi; }
__device__ __forceinline__ unsigned cvtpk(float lo, float hi) { unsigned r; asm volatile("v_cvt_pk_bf16_f32 %0, %1, %2" : "=v"(r) : "v"(lo), "v"(hi)); return r; }
constexpr float THRN = 8.f;

typedef float f32x2v __attribute__((ext_vector_type(2)));
__device__ __forceinline__ void partialSM(f32x16& p0, f32x16& p1, float& m_reg, float& mn, float& alpha, const float C, const float thrS) {
  float pmax = p0[0];
#pragma unroll
  for (int r = 1; r < 16; ++r) pmax = fmaxf(pmax, p0[r]);
#pragma unroll
  for (int r = 0; r < 16; ++r) pmax = fmaxf(pmax, p1[r]);
  { auto rr = __builtin_amdgcn_permlane32_swap(__float_as_uint(pmax), __float_as_uint(pmax), false, false);
    pmax = fmaxf(__uint_as_float(rr[0]), __uint_as_float(rr[1])); }
  if (__builtin_expect(__all(pmax - m_reg <= thrS), 1)) { mn = m_reg; alpha = 1.f; }
  else { mn = fmaxf(m_reg, pmax); alpha = __builtin_amdgcn_exp2f((m_reg - mn) * C); m_reg = mn; }
  const float mnC = -mn * C;
#pragma unroll
  for (int r = 0; r < 16; ++r) p0[r] = fmaf(p0[r], C, mnC);
#pragma unroll
  for (int r = 0; r < 16; ++r) p1[r] = fmaf(p1[r], C, mnC);
#pragma unroll
  for (int r = 0; r < 16; ++r) p0[r] = __builtin_amdgcn_exp2f(p0[r]);
}
__device__ __forceinline__ void finishSM(f32x16& p0, f32x16& p1, float alpha, float& l_reg, bf16x8& pa0, bf16x8& pa1, bf16x8& pa2, bf16x8& pa3) {
#pragma unroll
  for (int r = 0; r < 16; ++r) p1[r] = __builtin_amdgcn_exp2f(p1[r]);
  float ps = 0;
#pragma unroll
  for (int r = 0; r < 16; ++r) ps += p0[r];
#pragma unroll
  for (int r = 0; r < 16; ++r) ps += p1[r];
  { auto rr = __builtin_amdgcn_permlane32_swap(__float_as_uint(ps), __float_as_uint(ps), false, false);
    ps = __uint_as_float(rr[0]) + __uint_as_float(rr[1]); }
  l_reg = l_reg * alpha + ps;
#define PK4(P, BASE, OUT) do { unsigned a0 = cvtpk(P[BASE + 0], P[BASE + 1]), a1 = cvtpk(P[BASE + 2], P[BASE + 3]);   \
    unsigned b0 = cvtpk(P[BASE + 4], P[BASE + 5]), b1 = cvtpk(P[BASE + 6], P[BASE + 7]);                              \
    auto r0 = __builtin_amdgcn_permlane32_swap(a0, b0, false, false); auto r1 = __builtin_amdgcn_permlane32_swap(a1, b1, false, false); \
    u32x4 w = {r0[0], r1[0], r0[1], r1[1]}; OUT = *reinterpret_cast<bf16x8*>(&w); } while (0)
  PK4(p0, 0, pa0); PK4(p0, 8, pa1); PK4(p1, 0, pa2); PK4(p1, 8, pa3);
#undef PK4
}
template <int DQK>
__device__ __forceinline__ int kswz(int row, int colB) { return row * (DQK * 2) + (colB ^ ((row & 7) << 4)); }
template <int DQK, int NQR>
__device__ __forceinline__ void qkt(f32x16& p0, f32x16& p1, const char* Ks, const bf16x8* qr, const char* qls, int r32, int hi) {
  constexpr int N = DQK / 16;
  const char* k0p = Ks + (r32 ^ ((r32 >> 4) & 1)) * (DQK * 2); const char* k1p = k0p + 32 * (DQK * 2); const int swz = (r32 & 7) << 4;
  p0 = f32x16{}; p1 = f32x16{};
  bf16x8 c0 = *reinterpret_cast<const bf16x8*>(k0p + ((hi * 16) ^ swz)), c1 = *reinterpret_cast<const bf16x8*>(k1p + ((hi * 16) ^ swz));
  bf16x8 cq = c0; if (NQR == 0) cq = *reinterpret_cast<const bf16x8*>(qls);
#pragma unroll
  for (int d0 = 0; d0 < N; ++d0) {
    bf16x8 n0 = c0, n1 = c1, nq = cq;
    if (d0 + 1 < N) { const int cb = ((d0 + 1) * 32 + hi * 16) ^ swz;
      n0 = *reinterpret_cast<const bf16x8*>(k0p + cb); n1 = *reinterpret_cast<const bf16x8*>(k1p + cb);
      if (d0 + 1 >= NQR) nq = *reinterpret_cast<const bf16x8*>(qls + (d0 + 1 - NQR) * 1024); }
    SBAR();
    const bf16x8 qf = (d0 < NQR) ? qr[d0 < NQR ? d0 : 0] : cq;
    p0 = __builtin_amdgcn_mfma_f32_32x32x16_bf16(c0, qf, p0, 0, 0, 0);
    p1 = __builtin_amdgcn_mfma_f32_32x32x16_bf16(c1, qf, p1, 0, 0, 0);
    SBAR();
    c0 = n0; c1 = n1; cq = nq;
  }
}
template <int DV>
__device__ __forceinline__ int v_st(int k, int c) { const int kk = (k & ~0xC) | ((k & 4) << 1) | ((k & 8) >> 1); return ((kk >> 3) * (DV / 32) + (c >> 5)) * 512 + ((kk & 7) * 32 + (c & 31)) * 2; }
__device__ __forceinline__ int v_rd_base(int lane) { return ((lane & 3) << 3) | (((lane >> 2) & 3) << 6) | (((lane >> 4) & 1) << 5) | (((lane >> 5) & 1) << 8); }
template <int DV> constexpr int v_rd_off(int d0, int ks, int half) { return d0 * 512 + ks * (2 * (DV / 32) * 512) + half * ((DV / 32) * 512); }
template <int OFF> __device__ __forceinline__ s16x4 tr_read(int vb) {
  s16x4 r; asm volatile("ds_read_b64_tr_b16 %0, %1 offset:%2" : "=&v"(r) : "v"(vb), "i"(OFF) : "memory"); return r;
}
template <int OFF> __device__ __forceinline__ bf16x8 lds_read128(int addr) {
  bf16x8 r; asm volatile("ds_read_b128 %0, %1 offset:%2" : "=&v"(r) : "v"(addr), "i"(OFF) : "memory"); return r;
}
template <int N> __device__ __forceinline__ void lgkm_wait() {
  if constexpr (N <= 0) asm volatile("s_waitcnt lgkmcnt(0)" ::: "memory");
  else if constexpr (N == 1) asm volatile("s_waitcnt lgkmcnt(1)" ::: "memory");
  else if constexpr (N == 2) asm volatile("s_waitcnt lgkmcnt(2)" ::: "memory");
  else if constexpr (N == 3) asm volatile("s_waitcnt lgkmcnt(3)" ::: "memory");
  else if constexpr (N == 4) asm volatile("s_waitcnt lgkmcnt(4)" ::: "memory");
  else if constexpr (N == 5) asm volatile("s_waitcnt lgkmcnt(5)" ::: "memory");
  else if constexpr (N == 6) asm volatile("s_waitcnt lgkmcnt(6)" ::: "memory");
  else if constexpr (N == 7) asm volatile("s_waitcnt lgkmcnt(7)" ::: "memory");
  else if constexpr (N == 8) asm volatile("s_waitcnt lgkmcnt(8)" ::: "memory");
  else asm volatile("s_waitcnt lgkmcnt(9)" ::: "memory");
}
template <int DV, int I> __device__ __forceinline__ void pv_issue(int vb, s16x4& l, s16x4& h) {
  constexpr int ND0 = DV / 32, ks = I / ND0, d0 = I % ND0;
  l = tr_read<v_rd_off<DV>(d0, ks, 0)>(vb); h = tr_read<v_rd_off<DV>(d0, ks, 1)>(vb);
}
template <int DV, int I> __device__ __forceinline__ void pv_step(f32x16* o, int vb, const bf16x8 (&pa)[4], s16x4 (&L)[4], s16x4 (&H)[4]) {
  constexpr int ND0 = DV / 32, NM = 4 * ND0, ks = I / ND0, d0 = I % ND0;
  if constexpr (I + 3 < NM) pv_issue<DV, I + 3>(vb, L[(I + 3) & 3], H[(I + 3) & 3]);
  constexpr int ahead = (NM - 1 - I) < 3 ? (NM - 1 - I) : 3;
  lgkm_wait<2 * ahead>(); SBAR();
  const s16x4 l = L[I & 3], h = H[I & 3];
  o[d0] = __builtin_amdgcn_mfma_f32_32x32x16_bf16(pa[ks], (bf16x8){l[0], l[1], l[2], l[3], h[0], h[1], h[2], h[3]}, o[d0], 0, 0, 0);
  SBAR();
  if constexpr (I + 1 < NM) pv_step<DV, I + 1>(o, vb, pa, L, H);
}
template <int DV> __device__ __forceinline__ void pv_pipe(f32x16* o, int vb, bf16x8 pa0, bf16x8 pa1, bf16x8 pa2, bf16x8 pa3) {
  const bf16x8 pa[4] = {pa0, pa1, pa2, pa3}; s16x4 L[4], H[4];
  SBAR();
  pv_issue<DV, 0>(vb, L[0], H[0]); pv_issue<DV, 1>(vb, L[1], H[1]); pv_issue<DV, 2>(vb, L[2], H[2]);
  pv_step<DV, 0>(o, vb, pa, L, H);
}
template <int DQK, int NQR, int D> __device__ __forceinline__ void qk_issue(const int (&ka)[4], int qaddr, bf16x8& b0, bf16x8& b1, bf16x8& q) {
  constexpr int off = (D >> 2) * 128;
  b0 = lds_read128<off>(ka[D & 3]); b1 = lds_read128<off + 32 * DQK * 2>(ka[D & 3]);
  if constexpr (D >= NQR) q = lds_read128<(D - NQR) * 1024>(qaddr);
}
template <int DQK, int NQR, int A> constexpr int qk_reads_after(int d) {
  int n = 0; for (int e = d + 1; e <= d + A && e < DQK / 16; ++e) n += (e >= NQR) ? 3 : 2; return n;
}
template <int DQK, int NQR, int QD, int D> __device__ __forceinline__ void qk_step(f32x16& p0, f32x16& p1, const int (&ka)[4], int qaddr, const bf16x8* qr,
                                                                                bf16x8 (&B0)[QD + 1], bf16x8 (&B1)[QD + 1], bf16x8 (&Q)[QD + 1]) {
  constexpr int N = DQK / 16;
  if constexpr (D + QD < N) qk_issue<DQK, NQR, D + QD>(ka, qaddr, B0[(D + QD) % (QD + 1)], B1[(D + QD) % (QD + 1)], Q[(D + QD) % (QD + 1)]);
  lgkm_wait<qk_reads_after<DQK, NQR, QD>(D)>(); SBAR();
  bf16x8 qf; if constexpr (D < NQR) qf = qr[D < NQR ? D : 0]; else qf = Q[D % (QD + 1)];
  if constexpr (D == 0) { p0 = __builtin_amdgcn_mfma_f32_32x32x16_bf16(B0[0], qf, f32x16{}, 0, 0, 0); p1 = __builtin_amdgcn_mfma_f32_32x32x16_bf16(B1[0], qf, f32x16{}, 0, 0, 0); }
  else { p0 = __builtin_amdgcn_mfma_f32_32x32x16_bf16(B0[D % (QD + 1)], qf, p0, 0, 0, 0); p1 = __builtin_amdgcn_mfma_f32_32x32x16_bf16(B1[D % (QD + 1)], qf, p1, 0, 0, 0); }
  SBAR();
  if constexpr (D + 1 < N) qk_step<DQK, NQR, QD, D + 1>(p0, p1, ka, qaddr, qr, B0, B1, Q);
}
template <int DQK, int NQR, int QD> __device__ __forceinline__ void qk_pipe(f32x16& p0, f32x16& p1, int kbase, const int (&kx)[4], int qaddr, const bf16x8* qr) {
  int ka[4];
#pragma unroll
  for (int j = 0; j < 4; ++j) ka[j] = kbase + kx[j];
  bf16x8 B0[QD + 1], B1[QD + 1], Q[QD + 1];
  SBAR();
#pragma unroll
  for (int d = 0; d < QD; ++d) { if (d == 0) qk_issue<DQK, NQR, 0>(ka, qaddr, B0[0], B1[0], Q[0]); if (d == 1) qk_issue<DQK, NQR, 1>(ka, qaddr, B0[1 % (QD + 1)], B1[1 % (QD + 1)], Q[1 % (QD + 1)]); }
  qk_step<DQK, NQR, QD, 0>(p0, p1, ka, qaddr, qr, B0, B1, Q);
}
template <int DV, int D0> __device__ __forceinline__ void pv_one(f32x16& od, int vb, bf16x8 pa0, bf16x8 pa1, bf16x8 pa2, bf16x8 pa3) {
  const s16x4 l0 = tr_read<v_rd_off<DV>(D0, 0, 0)>(vb), h0 = tr_read<v_rd_off<DV>(D0, 0, 1)>(vb), l1 = tr_read<v_rd_off<DV>(D0, 1, 0)>(vb), h1 = tr_read<v_rd_off<DV>(D0, 1, 1)>(vb);
  const s16x4 l2 = tr_read<v_rd_off<DV>(D0, 2, 0)>(vb), h2 = tr_read<v_rd_off<DV>(D0, 2, 1)>(vb), l3 = tr_read<v_rd_off<DV>(D0, 3, 0)>(vb), h3 = tr_read<v_rd_off<DV>(D0, 3, 1)>(vb);
  asm volatile("s_waitcnt lgkmcnt(0)" ::: "memory"); SBAR();
#define PK(L, H) (bf16x8){L[0], L[1], L[2], L[3], H[0], H[1], H[2], H[3]}
  od = __builtin_amdgcn_mfma_f32_32x32x16_bf16(pa0, PK(l0, h0), od, 0, 0, 0);
  od = __builtin_amdgcn_mfma_f32_32x32x16_bf16(pa1, PK(l1, h1), od, 0, 0, 0);
  od = __builtin_amdgcn_mfma_f32_32x32x16_bf16(pa2, PK(l2, h2), od, 0, 0, 0);
  od = __builtin_amdgcn_mfma_f32_32x32x16_bf16(pa3, PK(l3, h3), od, 0, 0, 0);
#undef PK
}
template <int DV> __device__ __forceinline__ void pv_all(f32x16* o, int vb, bf16x8 pa0, bf16x8 pa1, bf16x8 pa2, bf16x8 pa3) {
  pv_one<DV, 0>(o[0], vb, pa0, pa1, pa2, pa3); pv_one<DV, 1>(o[1], vb, pa0, pa1, pa2, pa3);
  if constexpr (DV == 128) { pv_one<DV, 2>(o[2], vb, pa0, pa1, pa2, pa3); pv_one<DV, 3>(o[3], vb, pa0, pa1, pa2, pa3); }
}
__device__ __forceinline__ void smA(f32x16& p, float& m_reg, float& alpha, const float C, const float thrS) {
  float pmax = p[0];
#pragma unroll
  for (int r = 1; r < 16; ++r) pmax = fmaxf(pmax, p[r]);
  { auto rr = __builtin_amdgcn_permlane32_swap(__float_as_uint(pmax), __float_as_uint(pmax), false, false);
    pmax = fmaxf(__uint_as_float(rr[0]), __uint_as_float(rr[1])); }
  float mn;
  if (__builtin_expect(__all(pmax - m_reg <= thrS), 1)) { mn = m_reg; alpha = 1.f; }
  else { mn = fmaxf(m_reg, pmax); alpha = __builtin_amdgcn_exp2f((m_reg - mn) * C); m_reg = mn; }
  const float mnC = -mn * C;
#pragma unroll
  for (int r = 0; r < 16; ++r) p[r] = __builtin_amdgcn_exp2f(fmaf(p[r], C, mnC));
}
__device__ __forceinline__ void smB(const f32x16& p, float alpha, float& l_reg, bf16x8& pa0, bf16x8& pa1) {
  float ps = 0;
#pragma unroll
  for (int r = 0; r < 16; ++r) ps += p[r];
  { auto rr = __builtin_amdgcn_permlane32_swap(__float_as_uint(ps), __float_as_uint(ps), false, false);
    ps = __uint_as_float(rr[0]) + __uint_as_float(rr[1]); }
  l_reg = l_reg * alpha + ps;
#define PK4(P, BASE, OUT) do { unsigned a0 = cvtpk(P[BASE + 0], P[BASE + 1]), a1 = cvtpk(P[BASE + 2], P[BASE + 3]);   \
    unsigned b0 = cvtpk(P[BASE + 4], P[BASE + 5]), b1 = cvtpk(P[BASE + 6], P[BASE + 7]);                              \
    auto r0 = __builtin_amdgcn_permlane32_swap(a0, b0, false, false); auto r1 = __builtin_amdgcn_permlane32_swap(a1, b1, false, false); \
    u32x4 w = {r0[0], r1[0], r0[1], r1[1]}; OUT = *reinterpret_cast<bf16x8*>(&w); } while (0)
  PK4(p, 0, pa0); PK4(p, 8, pa1);
#undef PK4
}
template <int DQK, int NQR>
__device__ __forceinline__ void qk_half(f32x16& p, const char* Ks, int rb, const bf16x8* qr, const char* qls, int r32, int hi) {
  p = f32x16{};
#pragma unroll
  for (int d0 = 0; d0 < DQK / 16; ++d0) { const int cb = (d0 * 16 + hi * 8) * 2;
    bf16x8 b0 = *reinterpret_cast<const bf16x8*>(Ks + kswz<DQK>(rb + r32, cb));
    bf16x8 qf; if (d0 < NQR) qf = qr[d0]; else qf = *reinterpret_cast<const bf16x8*>(qls + (d0 - NQR) * 1024);
    p = __builtin_amdgcn_mfma_f32_32x32x16_bf16(b0, qf, p, 0, 0, 0); }
}
template <int DV, int D0, int KS0> __device__ __forceinline__ void pvh_one(f32x16& od, int vb, bf16x8 pa0, bf16x8 pa1) {
  const s16x4 l0 = tr_read<v_rd_off<DV>(D0, KS0, 0)>(vb), h0 = tr_read<v_rd_off<DV>(D0, KS0, 1)>(vb), l1 = tr_read<v_rd_off<DV>(D0, KS0 + 1, 0)>(vb), h1 = tr_read<v_rd_off<DV>(D0, KS0 + 1, 1)>(vb);
  asm volatile("s_waitcnt lgkmcnt(0)" ::: "memory"); SBAR();
#define PK(L, H) (bf16x8){L[0], L[1], L[2], L[3], H[0], H[1], H[2], H[3]}
  od = __builtin_amdgcn_mfma_f32_32x32x16_bf16(pa0, PK(l0, h0), od, 0, 0, 0);
  od = __builtin_amdgcn_mfma_f32_32x32x16_bf16(pa1, PK(l1, h1), od, 0, 0, 0);
#undef PK
}
template <int DV, int KS0> __device__ __forceinline__ void pv_half(f32x16* o, int vb, bf16x8 pa0, bf16x8 pa1) {
  pvh_one<DV, 0, KS0>(o[0], vb, pa0, pa1); pvh_one<DV, 1, KS0>(o[1], vb, pa0, pa1);
  if constexpr (DV == 128) { pvh_one<DV, 2, KS0>(o[2], vb, pa0, pa1); pvh_one<DV, 3, KS0>(o[3], vb, pa0, pa1); }
}
__device__ __forceinline__ void na_mask_half(f32x16& p, int kr, int coff, int qrow_g, int qc, int hi, const float* btab) {
  const int rs = min(max(qrow_g - 4, 0), 120), cs = min(max(qc - 8, 0), 48);
  const bool rowok = (kr >= rs) && (kr < rs + 8);
  const int ri = min(max(kr - qrow_g + 7, 0), 14);
  const float* brow = btab + ri * 31;
#pragma unroll
  for (int i = 0; i < 16; ++i) {
    const int kc = coff + crow(i, hi);
    const bool ok = rowok && kc >= cs && kc < cs + 16;
    const float bv = brow[min(max(kc - qc + 15, 0), 30)];
    p[i] = ok ? p[i] + bv : -1e30f;
  }
}
__device__ __forceinline__ void na_mask(f32x16& p0, f32x16& p1, int kr, int qrow_g, int qc, int hi, const float* btab) {
  const int rs = min(max(qrow_g - 4, 0), 120), cs = min(max(qc - 8, 0), 48);
  const bool rowok = (kr >= rs) && (kr < rs + 8);
  const int ri = min(max(kr - qrow_g + 7, 0), 14);
  const float* brow = btab + ri * 31;
#pragma unroll
  for (int i = 0; i < 16; ++i) {
    const int kc0 = crow(i, hi), kc1 = 32 + kc0;
    const bool ok0 = rowok && kc0 >= cs && kc0 < cs + 16, ok1 = rowok && kc1 >= cs && kc1 < cs + 16;
    const float b0 = brow[min(max(kc0 - qc + 15, 0), 30)], b1 = brow[min(max(kc1 - qc + 15, 0), 30)];
    p0[i] = ok0 ? p0[i] + b0 : -1e30f; p1[i] = ok1 ? p1[i] + b1 : -1e30f;
  }
}

struct NoFill { template <int D, int NSTEP> __device__ __forceinline__ void run() const {} };
struct ExpFill { f32x16* p; float C, mnC;
  template <int D, int NSTEP> __device__ __forceinline__ void run() const {
    constexpr int e0 = 16 * D / NSTEP, e1 = 16 * (D + 1) / NSTEP;
#pragma unroll
    for (int e = e0; e < e1; ++e) (*p)[e] = __builtin_amdgcn_exp2f(fmaf((*p)[e], C, mnC));
  } };
#define SBARV() __builtin_amdgcn_sched_barrier(0x0406)
template <int DV, int KS0, int I> __device__ __forceinline__ void pvh_issue(int vb, s16x4& l, s16x4& h) {
  constexpr int ND0 = DV / 32, ks = KS0 + I / ND0, d0 = I % ND0;
  l = tr_read<v_rd_off<DV>(d0, ks, 0)>(vb); h = tr_read<v_rd_off<DV>(d0, ks, 1)>(vb);
}
template <int DV, int KS0, int I, class Fill> __device__ __forceinline__ void pvh_step(f32x16* o, int vb, const bf16x8 (&pa)[2], s16x4 (&L)[4], s16x4 (&H)[4], const Fill& F) {
  constexpr int ND0 = DV / 32, NM = 2 * ND0, kk = I / ND0, d0 = I % ND0;
  if constexpr (I + 3 < NM) pvh_issue<DV, KS0, I + 3>(vb, L[(I + 3) & 3], H[(I + 3) & 3]);
  constexpr int ahead = (NM - 1 - I) < 3 ? (NM - 1 - I) : 3;
  lgkm_wait<2 * ahead>(); SBAR();
  const s16x4 l = L[I & 3], h = H[I & 3];
  o[d0] = __builtin_amdgcn_mfma_f32_32x32x16_bf16(pa[kk], (bf16x8){l[0], l[1], l[2], l[3], h[0], h[1], h[2], h[3]}, o[d0], 0, 0, 0);
  SBAR();
  F.template run<I, NM>();
  SBAR();
  if constexpr (I + 1 < NM) pvh_step<DV, KS0, I + 1, Fill>(o, vb, pa, L, H, F);
}
template <int DV, int KS0, class Fill> __device__ __forceinline__ void pvh_pipe(f32x16* o, int vb, bf16x8 pa0, bf16x8 pa1, const Fill& F) {
  const bf16x8 pa[2] = {pa0, pa1}; s16x4 L[4], H[4];
  SBAR();
  pvh_issue<DV, KS0, 0>(vb, L[0], H[0]); pvh_issue<DV, KS0, 1>(vb, L[1], H[1]); pvh_issue<DV, KS0, 2>(vb, L[2], H[2]);
  pvh_step<DV, KS0, 0, Fill>(o, vb, pa, L, H, F);
}
template <int DQK, int NQR, int HALF_, int D> __device__ __forceinline__ void qkh_issue(const int (&ka)[4], int qaddr, bf16x8& b, bf16x8& q) {
  constexpr int off = (D >> 2) * 128 + HALF_ * 32 * DQK * 2;
  b = lds_read128<off>(ka[D & 3]);
  if constexpr (D >= NQR) q = lds_read128<(D - NQR) * 1024>(qaddr);
}
template <int DQK, int NQR, int A> constexpr int qkh_reads_after(int d) {
  int n = 0; for (int e = d + 1; e <= d + A && e < DQK / 16; ++e) n += (e >= NQR) ? 2 : 1; return n;
}
template <int DQK, int NQR, int HALF_, int D, class Fill> __device__ __forceinline__ void qkh_step(f32x16& p, const int (&ka)[4], int qaddr, const bf16x8* qr, bf16x8 (&B)[4], bf16x8 (&Q)[4], const Fill& F) {
  constexpr int N = DQK / 16, QDH = 3;
  if constexpr (D + QDH < N) qkh_issue<DQK, NQR, HALF_, D + QDH>(ka, qaddr, B[(D + QDH) & 3], Q[(D + QDH) & 3]);
  lgkm_wait<qkh_reads_after<DQK, NQR, QDH>(D)>(); SBAR();
  bf16x8 qf; if constexpr (D < NQR) qf = qr[D < NQR ? D : 0]; else qf = Q[D & 3];
  if constexpr (D == 0) p = __builtin_amdgcn_mfma_f32_32x32x16_bf16(B[0], qf, f32x16{}, 0, 0, 0);
  else p = __builtin_amdgcn_mfma_f32_32x32x16_bf16(B[D & 3], qf, p, 0, 0, 0);
  SBAR();
  F.template run<D, N>();
  SBAR();
  if constexpr (D + 1 < N) qkh_step<DQK, NQR, HALF_, D + 1, Fill>(p, ka, qaddr, qr, B, Q, F);
}
template <int DQK, int NQR, int HALF_, class Fill> __device__ __forceinline__ void qkh_pipe(f32x16& p, int kbase, const int (&kx)[4], int qaddr, const bf16x8* qr, const Fill& F) {
  int ka[4];
#pragma unroll
  for (int j = 0; j < 4; ++j) ka[j] = kbase + kx[j];
  bf16x8 B[4], Q[4];
  SBAR();
  qkh_issue<DQK, NQR, HALF_, 0>(ka, qaddr, B[0], Q[0]); qkh_issue<DQK, NQR, HALF_, 1>(ka, qaddr, B[1], Q[1]); qkh_issue<DQK, NQR, HALF_, 2>(ka, qaddr, B[2], Q[2]);
  qkh_step<DQK, NQR, HALF_, 0, Fill>(p, ka, qaddr, qr, B, Q, F);
}
__device__ __forceinline__ float smA_pre(const f32x16& p, float& m_reg, float& alpha, const float C, const float thrS) {
  float pmax = p[0];
#pragma unroll
  for (int r = 1; r < 16; ++r) pmax = fmaxf(pmax, p[r]);
  { auto rr = __builtin_amdgcn_permlane32_swap(__float_as_uint(pmax), __float_as_uint(pmax), false, false);
    pmax = fmaxf(__uint_as_float(rr[0]), __uint_as_float(rr[1])); }
  float mn;
  if (__builtin_expect(__all(pmax - m_reg <= thrS), 1)) { mn = m_reg; alpha = 1.f; }
  else { mn = fmaxf(m_reg, pmax); alpha = __builtin_amdgcn_exp2f((m_reg - mn) * C); m_reg = mn; }
  return -mn * C;
}
template <int DQK, int DV, int NQL, bool NA>
__device__ __forceinline__ void attn_unit(const bf16_t* __restrict__ Qb, int ldq, const bf16_t* __restrict__ Kh, int ldk, const bf16_t* __restrict__ Vh, int ldv,
                                          bf16_t* __restrict__ Ob, int ldo, int NT, int skip, float scale, int na_r0, int na_krlo, char* lds, LAS unsigned char* ldsl) {
  constexpr int SHM_V = 64 * DV * 2, SHM_K = 64 * DQK * 2, NKC = DQK / 64, NVC = DV / 64, ND0 = DV / 32, NQ = DQK / 16, NQR = NQ - NQL, RING = 3 * (SHM_V + SHM_K);
  int tid_ = threadIdx.x; asm volatile("" : "+v"(tid_));
  const int tid = tid_, wid = __builtin_amdgcn_readfirstlane(tid >> 6), lane = tid & 63, r32 = lane & 31, hi = lane >> 5;
  char* V_lds = lds; char* K_lds = lds + 3 * SHM_V;
  float* ws = (float*)(lds + RING) + wid * 64; float* li_l = ws; float* al_l = ws + 32;
  char* qls = lds + RING + 2048 + wid * (NQL * 1024) + lane * 16;
  const float* btab = (const float*)(lds + 98304);
  const float C = scale * 1.4426950408889634f, thrS = THRN / scale;
  float m_reg = -1e30f, l_reg = 0; f32x16 o[ND0]; bf16x8 qr[NQR];
#pragma unroll
  for (int d = 0; d < ND0; ++d) o[d] = f32x16{};
  const bf16_t* Qw = Qb + (long)(wid * 32 + r32) * ldq + hi * 8;
#pragma unroll
  for (int d0 = 0; d0 < NQR; ++d0) qr[d0] = *reinterpret_cast<const bf16x8*>(Qw + d0 * 16);
#pragma unroll
  for (int d0 = 0; d0 < NQL; ++d0) *reinterpret_cast<bf16x8*>(qls + d0 * 1024) = *reinterpret_cast<const bf16x8*>(Qw + (NQR + d0) * 16);
  int kgo[NKC], vgo[NVC];
#pragma unroll
  for (int i = 0; i < NKC; ++i) { const int P = 64 * (wid + 8 * i) + lane, slot = P / (DQK / 8), row = slot ^ ((slot >> 4) & 1), cpos = P % (DQK / 8), cc = cpos ^ (row & 7); kgo[i] = row * ldk + cc * 8; }
#pragma unroll
  for (int i = 0; i < NVC; ++i) { const int P = 64 * (wid + 8 * i) + lane, sidx = P >> 5, within = P & 31, kk = (sidx / (DV / 32)) * 8 + (within >> 2), k = (kk & ~0xC) | ((kk & 4) << 1) | ((kk & 8) >> 1);
    vgo[i] = k * ldv + (sidx % (DV / 32)) * 32 + (within & 3) * 8; }
  const int vb0 = (int)(uintptr_t)V_lds + v_rd_base(lane);
  constexpr int QD = (NQL > 0) ? 1 : 2;
  const int kl0 = (int)(uintptr_t)K_lds + (r32 ^ ((r32 >> 4) & 1)) * (DQK * 2), qaddr = (int)(uintptr_t)qls;
  int kx[4];
#pragma unroll
  for (int j = 0; j < 4; ++j) kx[j] = (j * 32 + hi * 16) ^ ((r32 & 7) << 4);
  const int qrow_g = na_r0 + (wid >> 1), qc = 32 * (wid & 1) + r32;
#define KEY0(t) (64 * (t) + ((NA && (t) >= 4) ? skip : 0))
#define DMA(t, b) do { const long k0_ = KEY0(t); _Pragma("unroll") for (int i_ = 0; i_ < NVC; ++i_) \
      __builtin_amdgcn_global_load_lds((const unsigned*)(Vh + k0_ * ldv + vgo[i_]), (LAS unsigned*)(ldsl + (b) * SHM_V + (wid + 8 * i_) * 1024), 16, 0, 0); \
    _Pragma("unroll") for (int i_ = 0; i_ < NKC; ++i_) \
      __builtin_amdgcn_global_load_lds((const unsigned*)(Kh + k0_ * ldk + kgo[i_]), (LAS unsigned*)(ldsl + 3 * SHM_V + (b) * SHM_K + (wid + 8 * i_) * 1024), 16, 0, 0); } while (0)
#define RESC(a) do { if (__any((a) < 1.f)) { if (hi == 0) al_l[r32] = (a); asm volatile("s_waitcnt lgkmcnt(0)" ::: "memory"); \
    _Pragma("unroll") for (int d = 0; d < ND0; ++d) _Pragma("unroll") for (int r = 0; r < 16; ++r) o[d][r] *= al_l[crow(r, hi)]; } } while (0)
#define MASK(pa_, pb_, t) do { if constexpr (NA) { if ((t) >= 4) na_mask(pa_, pb_, na_krlo + (t) - 4, qrow_g, qc, hi, btab); } } while (0)
#define MASKH(p_, t, coff) do { if constexpr (NA) { if ((t) >= 4) na_mask_half(p_, na_krlo + (t) - 4, coff, qrow_g, qc, hi, btab); } } while (0)
#ifdef ATT_PINGPONG
  f32x16 p0, p1; float mn, al; bf16x8 pa0, pa1, pa2, pa3;
  const bool halfB = wid >= 4;
#define BARRIER() do { asm volatile("s_waitcnt lgkmcnt(0)" ::: "memory"); __builtin_amdgcn_s_barrier(); asm volatile("" ::: "memory"); } while (0)
#define XPOINT(t) do { asm volatile("s_waitcnt vmcnt(0)" ::: "memory"); BARRIER(); if ((t) + 2 < NT) { int fb_ = ((t) + 2) % 3; DMA((t) + 2, fb_); } } while (0)
  DMA(0, 0); if (1 < NT) DMA(1, 1);
  asm volatile("s_waitcnt vmcnt(0)" ::: "memory"); BARRIER();
  if (halfB) BARRIER();
  int buf = 0, pbuf = 0;
  for (int t = 0; t < NT; ++t) {
    SBAR();
    if (t > 0) pv_pipe<DV>(o, vb0 + pbuf * SHM_V, pa0, pa1, pa2, pa3);
    qk_pipe<DQK, NQR, QD>(p0, p1, kl0 + buf * SHM_K, kx, qaddr, qr);
    SBAR();
    if (halfB) XPOINT(t); else BARRIER();
    MASK(p0, p1, t);
    partialSM(p0, p1, m_reg, mn, al, C, thrS);
    RESC(al);
    finishSM(p0, p1, al, l_reg, pa0, pa1, pa2, pa3);
    SBAR();
    if (halfB) BARRIER(); else XPOINT(t);
    pbuf = buf; buf = buf + 1; if (buf == 3) buf = 0;
  }
  pv_pipe<DV>(o, vb0 + pbuf * SHM_V, pa0, pa1, pa2, pa3);
  asm volatile("s_waitcnt lgkmcnt(0)" ::: "memory");
  if (!halfB) BARRIER();
#undef BARRIER
#undef XPOINT
#elif defined(ATT_HALVES)
  f32x16 pA, pB; float alA, alB; bf16x8 pa0, pa1, pa2, pa3;
  DMA(0, 0); if (1 < NT) DMA(1, 1);
  asm volatile("s_waitcnt vmcnt(0) lgkmcnt(0)" ::: "memory"); __builtin_amdgcn_s_barrier(); asm volatile("" ::: "memory");
  int buf = 0;
  for (int t = 0; t < NT; ++t) {
    SBAR();
    qkh_pipe<DQK, NQR, 0>(pA, kl0 + buf * SHM_K, kx, qaddr, qr, NoFill{});
    MASKH(pA, t, 0);
    const float mnCa = smA_pre(pA, m_reg, alA, C, thrS);
    RESC(alA);
    SBAR();
    qkh_pipe<DQK, NQR, 1>(pB, kl0 + buf * SHM_K, kx, qaddr, qr, ExpFill{&pA, C, mnCa});
    smB(pA, alA, l_reg, pa0, pa1);
    MASKH(pB, t, 32);
    const float mnCb = smA_pre(pB, m_reg, alB, C, thrS);
    SBAR();
    pvh_pipe<DV, 0>(o, vb0 + buf * SHM_V, pa0, pa1, ExpFill{&pB, C, mnCb});
    smB(pB, alB, l_reg, pa2, pa3);
    RESC(alB);
    SBAR();
    pvh_pipe<DV, 2>(o, vb0 + buf * SHM_V, pa2, pa3, NoFill{});
    asm volatile("s_waitcnt vmcnt(0) lgkmcnt(0)" ::: "memory"); __builtin_amdgcn_s_barrier(); asm volatile("" ::: "memory");
    if (t + 2 < NT) { int fb_ = (t + 2) % 3; DMA(t + 2, fb_); }
    buf = buf + 1; if (buf == 3) buf = 0;
  }
#else
  f32x16 p0, p1; float mn, al; bf16x8 pa0, pa1, pa2, pa3;
  DMA(0, 0); if (1 < NT) DMA(1, 1);
  asm volatile("s_waitcnt vmcnt(0) lgkmcnt(0)" ::: "memory"); __builtin_amdgcn_s_barrier(); asm volatile("" ::: "memory");
  int buf = 0;
  for (int t = 0; t < NT; ++t) {
    bool act = true;
    if constexpr (NA) { if (t >= 4) { const int kr_ = na_krlo + t - 4, rs_ = min(max(qrow_g - 4, 0), 120); act = (kr_ >= rs_) && (kr_ < rs_ + 8); } }
    if (act) {
    qk_pipe<DQK, NQR, QD>(p0, p1, kl0 + buf * SHM_K, kx, qaddr, qr);
    MASK(p0, p1, t);
    partialSM(p0, p1, m_reg, mn, al, C, thrS);
    RESC(al);
    finishSM(p0, p1, al, l_reg, pa0, pa1, pa2, pa3);
    pv_pipe<DV>(o, vb0 + buf * SHM_V, pa0, pa1, pa2, pa3);
    }
    asm volatile("s_waitcnt vmcnt(0) lgkmcnt(0)" ::: "memory"); __builtin_amdgcn_s_barrier(); asm volatile("" ::: "memory");
    if (t + 2 < NT) { int fb_ = (t + 2) % 3; DMA(t + 2, fb_); }
    buf = buf + 1; if (buf == 3) buf = 0;
  }
#endif
  if (hi == 0) li_l[r32] = l_reg; asm volatile("s_waitcnt lgkmcnt(0)" ::: "memory");
  float rli[16];
#pragma unroll
  for (int r = 0; r < 16; ++r) rli[r] = __builtin_amdgcn_rcpf(li_l[crow(r, hi)]);
  bf16_t* Ow = Ob + (long)(wid * 32) * ldo;
#pragma unroll
  for (int r = 0; r < 16; ++r) { const int orow = crow(r, hi);
#pragma unroll
    for (int d0 = 0; d0 < ND0; ++d0) { const float v = o[d0][r] * rli[r]; unsigned u = __builtin_bit_cast(unsigned, v); u = (u + 0x7fffu + ((u >> 16) & 1u)) >> 16; Ow[(long)orow * ldo + d0 * 32 + r32] = (bf16_t)u; } }
  __syncthreads();
#undef KEY0
#undef DMA
#undef RESC
#undef MASK
#undef MASKH
}

template <int OFF> __device__ __forceinline__ long lds_read64(int addr) {
  long r; asm volatile("ds_read_b64 %0, %1 offset:%2" : "=&v"(r) : "v"(addr), "i"(OFF) : "memory"); return r;
}
template <int D> __device__ __forceinline__ void qk8_issue(const int (&ka)[4], long& b0, long& b1) {
  constexpr int off = (D >> 2) * 64;
  b0 = lds_read64<off>(ka[D & 3]); b1 = lds_read64<off + 32 * 192>(ka[D & 3]);
}
template <int D> __device__ __forceinline__ void qk8_step(f32x16& p0, f32x16& p1, const int (&ka)[4], const long* qr, long (&B0)[3], long (&B1)[3]) {
  constexpr int N = 12, QD8 = 2;
  if constexpr (D + QD8 < N) qk8_issue<D + QD8>(ka, B0[(D + QD8) % 3], B1[(D + QD8) % 3]);
  constexpr int after = (N - 1 - D) < QD8 ? (N - 1 - D) : QD8;
  lgkm_wait<2 * after>(); SBAR();
  if constexpr (D == 0) { p0 = __builtin_amdgcn_mfma_f32_32x32x16_fp8_fp8(B0[0], qr[0], f32x16{}, 0, 0, 0); p1 = __builtin_amdgcn_mfma_f32_32x32x16_fp8_fp8(B1[0], qr[0], f32x16{}, 0, 0, 0); }
  else { p0 = __builtin_amdgcn_mfma_f32_32x32x16_fp8_fp8(B0[D % 3], qr[D], p0, 0, 0, 0); p1 = __builtin_amdgcn_mfma_f32_32x32x16_fp8_fp8(B1[D % 3], qr[D], p1, 0, 0, 0); }
  SBAR();
  if constexpr (D + 1 < N) qk8_step<D + 1>(p0, p1, ka, qr, B0, B1);
}
__device__ __forceinline__ void qk8_pipe(f32x16& p0, f32x16& p1, int kbase, const int (&kx)[4], const long* qr) {
  int ka[4];
#pragma unroll
  for (int j = 0; j < 4; ++j) ka[j] = kbase + kx[j];
  long B0[3], B1[3];
  SBAR();
  qk8_issue<0>(ka, B0[0], B1[0]); qk8_issue<1>(ka, B0[1], B1[1]);
  qk8_step<0>(p0, p1, ka, qr, B0, B1);
}
__device__ __forceinline__ void attn_unit_f8k(const unsigned char* __restrict__ Qb, const unsigned char* __restrict__ Kh, const bf16_t* __restrict__ Vh, int ldv,
                                              bf16_t* __restrict__ Ob, int ldo, int NT, float scale, char* lds, LAS unsigned char* ldsl) {
  constexpr int DV = 128, LDB = 1536, SHM_V = 64 * DV * 2, SHM_K = 64 * 192, NVC = 2, ND0 = 4, RING = 3 * (SHM_V + SHM_K);
  int tid_ = threadIdx.x; asm volatile("" : "+v"(tid_));
  const int tid = tid_, wid = __builtin_amdgcn_readfirstlane(tid >> 6), lane = tid & 63, r32 = lane & 31, hi = lane >> 5;
  char* V_lds = lds; char* K_lds = lds + 3 * SHM_V;
  float* ws = (float*)(lds + RING) + wid * 64; float* li_l = ws; float* al_l = ws + 32;
  const float C = scale * 1.4426950408889634f, thrS = THRN / scale;
  float m_reg = -1e30f, l_reg = 0; f32x16 o[ND0]; long qr[12];
#pragma unroll
  for (int d = 0; d < ND0; ++d) o[d] = f32x16{};
  const unsigned char* Qw = Qb + (long)(wid * 32 + r32) * LDB + hi * 8;
#pragma unroll
  for (int d0 = 0; d0 < 12; ++d0) qr[d0] = *(const __attribute__((address_space(1))) long*)(Qw + d0 * 16);
  int kgo[2], vgo[NVC];
#pragma unroll
  for (int i = 0; i < 2; ++i) { const int P = 64 * (wid + 8 * i) + lane, slot = P / 12, cpos = P - slot * 12, row = slot ^ ((slot >> 4) & 1), c16 = cpos ^ ((slot >> 2) & 3); kgo[i] = row * LDB + c16 * 16; }
#pragma unroll
  for (int i = 0; i < NVC; ++i) { const int P = 64 * (wid + 8 * i) + lane, sidx = P >> 5, within = P & 31, kk = (sidx / (DV / 32)) * 8 + (within >> 2), k = (kk & ~0xC) | ((kk & 4) << 1) | ((kk & 8) >> 1);
    vgo[i] = k * ldv + (sidx % (DV / 32)) * 32 + (within & 3) * 8; }
  const int vb0 = (int)(uintptr_t)V_lds + v_rd_base(lane);
  const int slot32 = r32 ^ ((r32 >> 4) & 1);
  const int kl0 = (int)(uintptr_t)K_lds + slot32 * 192 + hi * 8;
  int kx[4];
#pragma unroll
  for (int j = 0; j < 4; ++j) kx[j] = (j ^ ((slot32 >> 2) & 3)) * 16;
#define DMA8(t, b) do { const long k0_ = 64 * (long)(t); _Pragma("unroll") for (int i_ = 0; i_ < NVC; ++i_) \
      __builtin_amdgcn_global_load_lds((const unsigned*)(Vh + k0_ * ldv + vgo[i_]), (LAS unsigned*)(ldsl + (b) * SHM_V + (wid + 8 * i_) * 1024), 16, 0, 0); \
    __builtin_amdgcn_global_load_lds((const unsigned*)(Kh + k0_ * LDB + kgo[0]), (LAS unsigned*)(ldsl + 3 * SHM_V + (b) * SHM_K + wid * 1024), 16, 0, 0); \
    if (wid < 4) __builtin_amdgcn_global_load_lds((const unsigned*)(Kh + k0_ * LDB + kgo[1]), (LAS unsigned*)(ldsl + 3 * SHM_V + (b) * SHM_K + (wid + 8) * 1024), 16, 0, 0); } while (0)
#define RESC8(a) do { if (__any((a) < 1.f)) { if (hi == 0) al_l[r32] = (a); asm volatile("s_waitcnt lgkmcnt(0)" ::: "memory"); \
    _Pragma("unroll") for (int d = 0; d < ND0; ++d) _Pragma("unroll") for (int r = 0; r < 16; ++r) o[d][r] *= al_l[crow(r, hi)]; } } while (0)
  f32x16 p0, p1; float mn, al; bf16x8 pa0, pa1, pa2, pa3;
  DMA8(0, 0); if (1 < NT) DMA8(1, 1);
  asm volatile("s_waitcnt vmcnt(0) lgkmcnt(0)" ::: "memory"); __builtin_amdgcn_s_barrier(); asm volatile("" ::: "memory");
  int buf = 0;
  for (int t = 0; t < NT; ++t) {
    qk8_pipe(p0, p1, kl0 + buf * SHM_K, kx, qr);
    partialSM(p0, p1, m_reg, mn, al, C, thrS);
    RESC8(al);
    finishSM(p0, p1, al, l_reg, pa0, pa1, pa2, pa3);
    pv_pipe<DV>(o, vb0 + buf * SHM_V, pa0, pa1, pa2, pa3);
    asm volatile("s_waitcnt vmcnt(0) lgkmcnt(0)" ::: "memory"); __builtin_amdgcn_s_barrier(); asm volatile("" ::: "memory");
    if (t + 2 < NT) { int fb_ = (t + 2) % 3; DMA8(t + 2, fb_); }
    buf = buf + 1; if (buf == 3) buf = 0;
  }
  if (hi == 0) li_l[r32] = l_reg; asm volatile("s_waitcnt lgkmcnt(0)" ::: "memory");
  float rli[16];
#pragma unroll
  for (int r = 0; r < 16; ++r) rli[r] = __builtin_amdgcn_rcpf(li_l[crow(r, hi)]);
  bf16_t* Ow = Ob + (long)(wid * 32) * ldo;
#pragma unroll
  for (int r = 0; r < 16; ++r) { const int orow = crow(r, hi);
#pragma unroll
    for (int d0 = 0; d0 < ND0; ++d0) { const float v = o[d0][r] * rli[r]; unsigned u = __builtin_bit_cast(unsigned, v); u = (u + 0x7fffu + ((u >> 16) & 1u)) >> 16; Ow[(long)orow * ldo + d0 * 32 + r32] = (bf16_t)u; } }
  __syncthreads();
#undef DMA8
#undef RESC8
}

__device__ __forceinline__ long pack_p8(const f32x16& p, int base) {
  int a = __builtin_amdgcn_cvt_pk_fp8_f32(p[base + 0], p[base + 1], 0, false); a = __builtin_amdgcn_cvt_pk_fp8_f32(p[base + 2], p[base + 3], a, true);
  int b = __builtin_amdgcn_cvt_pk_fp8_f32(p[base + 4], p[base + 5], 0, false); b = __builtin_amdgcn_cvt_pk_fp8_f32(p[base + 6], p[base + 7], b, true);
  auto r = __builtin_amdgcn_permlane32_swap((unsigned)a, (unsigned)b, false, false);
  return (long)(((unsigned long long)r[1] << 32) | (unsigned long long)r[0]);
}
template <int I> __device__ __forceinline__ void pv8_issue(int vb, const int (&vx)[4], long& v) {
  constexpr int s_ = I >> 2, d0 = I & 3;
  v = lds_read64<d0 * 2048>(vb + vx[s_]);
}
template <int I> __device__ __forceinline__ void pv8_step(f32x16* o, int vb, const int (&vx)[4], const long (&pa)[4], long (&V)[4]) {
  constexpr int NM = 16, s_ = I >> 2, d0 = I & 3;
  if constexpr (I + 3 < NM) pv8_issue<I + 3>(vb, vx, V[(I + 3) & 3]);
  constexpr int ahead = (NM - 1 - I) < 3 ? (NM - 1 - I) : 3;
  lgkm_wait<ahead>(); SBAR();
  o[d0] = __builtin_amdgcn_mfma_f32_32x32x16_fp8_fp8(pa[s_], V[I & 3], o[d0], 0, 0, 0);
  SBAR();
  if constexpr (I + 1 < NM) pv8_step<I + 1>(o, vb, vx, pa, V);
}
__device__ __forceinline__ void pv8_pipe(f32x16* o, int vb, const int (&vx)[4], const long (&pa)[4]) {
  long V[4];
  SBAR();
  pv8_issue<0>(vb, vx, V[0]); pv8_issue<1>(vb, vx, V[1]); pv8_issue<2>(vb, vx, V[2]);
  pv8_step<0>(o, vb, vx, pa, V);
}
__device__ __forceinline__ void attn_unit_f8kv(const unsigned char* __restrict__ Qb, const unsigned char* __restrict__ Kh, const unsigned char* __restrict__ Vt,
                                               bf16_t* __restrict__ Ob, int ldo, int NT, float scale, char* lds, LAS unsigned char* ldsl) {
  constexpr int LDB = 1536, SHM_V = 8192, SHM_K = 64 * 192, ND0 = 4, RING = 3 * (SHM_V + SHM_K);
  constexpr float THR8 = 5.5f;
  int tid_ = threadIdx.x; asm volatile("" : "+v"(tid_));
  const int tid = tid_, wid = __builtin_amdgcn_readfirstlane(tid >> 6), lane = tid & 63, r32 = lane & 31, hi = lane >> 5;
  char* V_lds = lds; char* K_lds = lds + 3 * SHM_V;
  float* ws = (float*)(lds + RING) + wid * 64; float* li_l = ws; float* al_l = ws + 32;
  const float C = scale * 1.4426950408889634f, thrS = THR8 / scale;
  float m_reg = -1e30f, l_reg = 0; f32x16 o[ND0]; long qr[12];
#pragma unroll
  for (int d = 0; d < ND0; ++d) o[d] = f32x16{};
  const unsigned char* Qw = Qb + (long)(wid * 32 + r32) * LDB + hi * 8;
#pragma unroll
  for (int d0 = 0; d0 < 12; ++d0) qr[d0] = *(const __attribute__((address_space(1))) long*)(Qw + d0 * 16);
  int kgo[2], vgo;
#pragma unroll
  for (int i = 0; i < 2; ++i) { const int P = 64 * (wid + 8 * i) + lane, slot = P / 12, cpos = P - slot * 12, row = slot ^ ((slot >> 4) & 1), c16 = cpos ^ ((slot >> 2) & 3); kgo[i] = row * LDB + c16 * 16; }
  { const int P = 64 * wid + lane, slot = P >> 2, cpos = P & 3, d = slot ^ ((slot >> 4) & 1), c16 = cpos ^ ((slot >> 2) & 3); vgo = d * 64 + c16 * 16; }
  const int slot32 = r32 ^ ((r32 >> 4) & 1), asw = (slot32 >> 2) & 3;
  const int kl0 = (int)(uintptr_t)K_lds + slot32 * 192 + hi * 8;
  const int vl0 = (int)(uintptr_t)V_lds + slot32 * 64 + hi * 8;
  int kx[4], vx[4];
#pragma unroll
  for (int j = 0; j < 4; ++j) { kx[j] = (j ^ asw) * 16; vx[j] = (j ^ asw) * 16; }
#define DMA8(t, b) do { const long t_ = (long)(t); \
    __builtin_amdgcn_global_load_lds((const unsigned*)(Vt + t_ * 8192 + vgo), (LAS unsigned*)(ldsl + (b) * SHM_V + wid * 1024), 16, 0, 0); \
    __builtin_amdgcn_global_load_lds((const unsigned*)(Kh + t_ * 64 * LDB + kgo[0]), (LAS unsigned*)(ldsl + 3 * SHM_V + (b) * SHM_K + wid * 1024), 16, 0, 0); \
    if (wid < 4) __builtin_amdgcn_global_load_lds((const unsigned*)(Kh + t_ * 64 * LDB + kgo[1]), (LAS unsigned*)(ldsl + 3 * SHM_V + (b) * SHM_K + (wid + 8) * 1024), 16, 0, 0); } while (0)
#define RESC8(a) do { if (__any((a) < 1.f)) { if (hi == 0) al_l[r32] = (a); asm volatile("s_waitcnt lgkmcnt(0)" ::: "memory"); \
    _Pragma("unroll") for (int d = 0; d < ND0; ++d) _Pragma("unroll") for (int r = 0; r < 16; ++r) o[d][r] *= al_l[crow(r, hi)]; } } while (0)
  f32x16 p0, p1; float mn, al;
  DMA8(0, 0); if (1 < NT) DMA8(1, 1);
  asm volatile("s_waitcnt vmcnt(0) lgkmcnt(0)" ::: "memory"); __builtin_amdgcn_s_barrier(); asm volatile("" ::: "memory");
  int buf = 0;
  for (int t = 0; t < NT; ++t) {
    qk8_pipe(p0, p1, kl0 + buf * SHM_K, kx, qr);
    partialSM(p0, p1, m_reg, mn, al, C, thrS);
    RESC8(al);
#pragma unroll
    for (int r = 0; r < 16; ++r) p1[r] = __builtin_amdgcn_exp2f(p1[r]);
    float ps = 0;
#pragma unroll
    for (int r = 0; r < 16; ++r) ps += p0[r];
#pragma unroll
    for (int r = 0; r < 16; ++r) ps += p1[r];
    { auto rr = __builtin_amdgcn_permlane32_swap(__float_as_uint(ps), __float_as_uint(ps), false, false); ps = __uint_as_float(rr[0]) + __uint_as_float(rr[1]); }
    l_reg = l_reg * al + ps;
    const long pa[4] = {pack_p8(p0, 0), pack_p8(p0, 8), pack_p8(p1, 0), pack_p8(p1, 8)};
    pv8_pipe(o, vl0 + buf * SHM_V, vx, pa);
    asm volatile("s_waitcnt vmcnt(0) lgkmcnt(0)" ::: "memory"); __builtin_amdgcn_s_barrier(); asm volatile("" ::: "memory");
    if (t + 2 < NT) { int fb_ = (t + 2) % 3; DMA8(t + 2, fb_); }
    buf = buf + 1; if (buf == 3) buf = 0;
  }
  if (hi == 0) li_l[r32] = l_reg; asm volatile("s_waitcnt lgkmcnt(0)" ::: "memory");
  float rli[16];
#pragma unroll
  for (int r = 0; r < 16; ++r) rli[r] = __builtin_amdgcn_rcpf(li_l[crow(r, hi)]);
  bf16_t* Ow = Ob + (long)(wid * 32) * ldo;
#pragma unroll
  for (int r = 0; r < 16; ++r) { const int orow = crow(r, hi);
#pragma unroll
    for (int d0 = 0; d0 < ND0; ++d0) { const float v = o[d0][r] * rli[r]; unsigned u = __builtin_bit_cast(unsigned, v); u = (u + 0x7fffu + ((u >> 16) & 1u)) >> 16; Ow[(long)orow * ldo + d0 * 32 + r32] = (bf16_t)u; } }
  __syncthreads();
#undef DMA8
#undef RESC8
}

typedef int i32x8 __attribute__((ext_vector_type(8)));
typedef int i32x4 __attribute__((ext_vector_type(4)));
template <int OFF> __device__ __forceinline__ i32x4 lds_read128i(int addr) {
  i32x4 r; asm volatile("ds_read_b128 %0, %1 offset:%2" : "=&v"(r) : "v"(addr), "i"(OFF) : "memory"); return r;
}
__device__ __forceinline__ i32x8 cat8(const i32x4 a, const i32x4 b) { return (i32x8){a[0], a[1], a[2], a[3], b[0], b[1], b[2], b[3]}; }
#define MFMA_S8(A_, B_, C_) __builtin_amdgcn_mfma_scale_f32_32x32x64_f8f6f4(A_, B_, C_, 0, 0, 0, 127, 0, 127)
template <int S> __device__ __forceinline__ void qks_issue(const int (&ka)[2], i32x4& x0, i32x4& x1) {
  constexpr int c = S >> 1, half = S & 1, off = c * 64 + half * 32 * 192;
  x0 = lds_read128i<off>(ka[0]); x1 = lds_read128i<off>(ka[1]);
}
template <int S> __device__ __forceinline__ void qks_step(f32x16& p0, f32x16& p1, const int (&ka)[2], const i32x8* qv, i32x4 (&X0)[3], i32x4 (&X1)[3]) {
  constexpr int N = 6, c = S >> 1, half = S & 1;
  if constexpr (S + 2 < N) qks_issue<S + 2>(ka, X0[(S + 2) % 3], X1[(S + 2) % 3]);
  constexpr int after = (N - 1 - S) < 2 ? (N - 1 - S) : 2;
  lgkm_wait<2 * after>(); SBAR();
  const i32x8 kf = cat8(X0[S % 3], X1[S % 3]);
  if constexpr (half == 0) { if constexpr (c == 0) p0 = MFMA_S8(kf, qv[c], f32x16{}); else p0 = MFMA_S8(kf, qv[c], p0); }
  else { if constexpr (c == 0) p1 = MFMA_S8(kf, qv[c], f32x16{}); else p1 = MFMA_S8(kf, qv[c], p1); }
  SBAR();
  if constexpr (S + 1 < N) qks_step<S + 1>(p0, p1, ka, qv, X0, X1);
}
template <int D0> __device__ __forceinline__ void pvs_issue(const int (&va)[2], i32x4& x0, i32x4& x1) { x0 = lds_read128i<D0 * 2048>(va[0]); x1 = lds_read128i<D0 * 2048>(va[1]); }
template <int D0> __device__ __forceinline__ void pvs_step(f32x16* o, const int (&va)[2], const i32x8& pf, i32x4 (&X0)[3], i32x4 (&X1)[3]) {
  constexpr int N = 4;
  if constexpr (D0 + 2 < N) pvs_issue<D0 + 2>(va, X0[(D0 + 2) % 3], X1[(D0 + 2) % 3]);
  constexpr int after = (N - 1 - D0) < 2 ? (N - 1 - D0) : 2;
  lgkm_wait<2 * after>(); SBAR();
  o[D0] = MFMA_S8(pf, cat8(X0[D0 % 3], X1[D0 % 3]), o[D0]);
  SBAR();
  if constexpr (D0 + 1 < N) pvs_step<D0 + 1>(o, va, pf, X0, X1);
}
__device__ __forceinline__ int pack4_fp8(float a, float b, float c, float d) { int w = __builtin_amdgcn_cvt_pk_fp8_f32(a, b, 0, false); return __builtin_amdgcn_cvt_pk_fp8_f32(c, d, w, true); }
__device__ __forceinline__ void attn_unit_f8s(const unsigned char* __restrict__ Qb, const unsigned char* __restrict__ Kh, const unsigned char* __restrict__ Vt,
                                              bf16_t* __restrict__ Ob, int ldo, int NT, float scale, char* lds, LAS unsigned char* ldsl) {
  constexpr int LDB = 1536, SHM_V = 8192, SHM_K = 64 * 192, ND0 = 4, RING = 3 * (SHM_V + SHM_K);
  constexpr float THR8 = 5.5f;
  int tid_ = threadIdx.x; asm volatile("" : "+v"(tid_));
  const int tid = tid_, wid = __builtin_amdgcn_readfirstlane(tid >> 6), lane = tid & 63, r32 = lane & 31, hi = lane >> 5;
  char* V_lds = lds; char* K_lds = lds + 3 * SHM_V;
  float* ws = (float*)(lds + RING) + wid * 64; float* li_l = ws; float* al_l = ws + 32;
  const float C = scale * 1.4426950408889634f, thrS = THR8 / scale;
  float m_reg = -1e30f, l_reg = 0; f32x16 o[ND0]; i32x8 qv[3];
#pragma unroll
  for (int d = 0; d < ND0; ++d) o[d] = f32x16{};
  const unsigned char* Qw = Qb + (long)(wid * 32 + r32) * LDB + hi * 32;
#pragma unroll
  for (int c = 0; c < 3; ++c) qv[c] = cat8(*(const __attribute__((address_space(1))) i32x4*)(Qw + c * 64), *(const __attribute__((address_space(1))) i32x4*)(Qw + c * 64 + 16));
  int kgo[2], vgo;
#pragma unroll
  for (int i = 0; i < 2; ++i) { const int P = 64 * (wid + 8 * i) + lane, slot = P / 12, cpos = P - slot * 12, row = slot ^ ((slot >> 4) & 1), c16 = cpos ^ ((slot >> 2) & 3); kgo[i] = row * LDB + c16 * 16; }
  { const int P = 64 * wid + lane, slot = P >> 2, cpos = P & 3, d = slot ^ ((slot >> 4) & 1), c16 = cpos ^ ((slot >> 2) & 3); vgo = d * 64 + c16 * 16; }
  const int slot32 = r32 ^ ((r32 >> 4) & 1), asw = (slot32 >> 2) & 3;
  const int kl0 = (int)(uintptr_t)K_lds + slot32 * 192, vl0 = (int)(uintptr_t)V_lds + slot32 * 64;
  int xo[2];
#pragma unroll
  for (int e = 0; e < 2; ++e) xo[e] = ((2 * hi + e) ^ asw) * 16;
#define DMA8(t, b) do { const long t_ = (long)(t); \
    __builtin_amdgcn_global_load_lds((const unsigned*)(Vt + t_ * 8192 + vgo), (LAS unsigned*)(ldsl + (b) * SHM_V + wid * 1024), 16, 0, 0); \
    __builtin_amdgcn_global_load_lds((const unsigned*)(Kh + t_ * 64 * LDB + kgo[0]), (LAS unsigned*)(ldsl + 3 * SHM_V + (b) * SHM_K + wid * 1024), 16, 0, 0); \
    if (wid < 4) __builtin_amdgcn_global_load_lds((const unsigned*)(Kh + t_ * 64 * LDB + kgo[1]), (LAS unsigned*)(ldsl + 3 * SHM_V + (b) * SHM_K + (wid + 8) * 1024), 16, 0, 0); } while (0)
#define RESC8(a) do { if (__any((a) < 1.f)) { if (hi == 0) al_l[r32] = (a); asm volatile("s_waitcnt lgkmcnt(0)" ::: "memory"); \
    _Pragma("unroll") for (int d = 0; d < ND0; ++d) _Pragma("unroll") for (int r = 0; r < 16; ++r) o[d][r] *= al_l[crow(r, hi)]; } } while (0)
  f32x16 p0, p1; float mn, al;
  DMA8(0, 0); if (1 < NT) DMA8(1, 1);
  asm volatile("s_waitcnt vmcnt(0) lgkmcnt(0)" ::: "memory"); __builtin_amdgcn_s_barrier(); asm volatile("" ::: "memory");
  int buf = 0;
  for (int t = 0; t < NT; ++t) {
    { int ka[2]; ka[0] = kl0 + buf * SHM_K + xo[0]; ka[1] = kl0 + buf * SHM_K + xo[1];
      i32x4 X0[3], X1[3];
      SBAR();
      qks_issue<0>(ka, X0[0], X1[0]); qks_issue<1>(ka, X0[1], X1[1]);
      qks_step<0>(p0, p1, ka, qv, X0, X1); }
    partialSM(p0, p1, m_reg, mn, al, C, thrS);
    RESC8(al);
#pragma unroll
    for (int r = 0; r < 16; ++r) p1[r] = __builtin_amdgcn_exp2f(p1[r]);
    float ps = 0;
#pragma unroll
    for (int r = 0; r < 16; ++r) ps += p0[r];
#pragma unroll
    for (int r = 0; r < 16; ++r) ps += p1[r];
    { auto rr = __builtin_amdgcn_permlane32_swap(__float_as_uint(ps), __float_as_uint(ps), false, false); ps = __uint_as_float(rr[0]) + __uint_as_float(rr[1]); }
    l_reg = l_reg * al + ps;
    const i32x8 pf = {pack4_fp8(p0[0], p0[1], p0[2], p0[3]), pack4_fp8(p0[4], p0[5], p0[6], p0[7]), pack4_fp8(p0[8], p0[9], p0[10], p0[11]), pack4_fp8(p0[12], p0[13], p0[14], p0[15]),
                      pack4_fp8(p1[0], p1[1], p1[2], p1[3]), pack4_fp8(p1[4], p1[5], p1[6], p1[7]), pack4_fp8(p1[8], p1[9], p1[10], p1[11]), pack4_fp8(p1[12], p1[13], p1[14], p1[15])};
    { int va[2]; va[0] = vl0 + buf * SHM_V + xo[0]; va[1] = vl0 + buf * SHM_V + xo[1];
      i32x4 X0[3], X1[3];
      SBAR();
      pvs_issue<0>(va, X0[0], X1[0]); pvs_issue<1>(va, X0[1], X1[1]);
      pvs_step<0>(o, va, pf, X0, X1); }
    asm volatile("s_waitcnt vmcnt(0) lgkmcnt(0)" ::: "memory"); __builtin_amdgcn_s_barrier(); asm volatile("" ::: "memory");
    if (t + 2 < NT) { int fb_ = (t + 2) % 3; DMA8(t + 2, fb_); }
    buf = buf + 1; if (buf == 3) buf = 0;
  }
  if (hi == 0) li_l[r32] = l_reg; asm volatile("s_waitcnt lgkmcnt(0)" ::: "memory");
  float rli[16];
#pragma unroll
  for (int r = 0; r < 16; ++r) rli[r] = __builtin_amdgcn_rcpf(li_l[crow(r, hi)]);
  bf16_t* Ow = Ob + (long)(wid * 32) * ldo;
#pragma unroll
  for (int r = 0; r < 16; ++r) { const int orow = crow(r, hi);
#pragma unroll
    for (int d0 = 0; d0 < ND0; ++d0) { const float v = o[d0][r] * rli[r]; unsigned u = __builtin_bit_cast(unsigned, v); u = (u + 0x7fffu + ((u >> 16) & 1u)) >> 16; Ow[(long)orow * ldo + d0 * 32 + r32] = (bf16_t)u; } }
  __syncthreads();
#undef DMA8
#undef RESC8
}
}
#define XB_TMO      128
#define XB_XCNT(j)  (256  + 64 * (j))
#define XB_XSUB(j)  (1280 + 64 * (j))
#define XB_XGEN(j)  (2304 + 64 * (j))
#define XB_TOP      3328
#define XB_TOPGEN   3392
#define XCD_BAR_WORDS 3456
#define XB_SPIN_CAP (1u << 22)

__device__ __forceinline__ unsigned xb_ld(unsigned* p)              { return __hip_atomic_load(p, __ATOMIC_RELAXED, __HIP_MEMORY_SCOPE_AGENT); }
__device__ __forceinline__ unsigned xb_add(unsigned* p, unsigned v) { return __hip_atomic_fetch_add(p, v, __ATOMIC_RELAXED, __HIP_MEMORY_SCOPE_AGENT); }
__device__ __forceinline__ unsigned xb_xcc_id() { return (unsigned)__builtin_amdgcn_s_getreg((3 << 11) | 20) & 0xFu; }
#define XB_SPIN(cond, bar) do { unsigned _sp = 0; while (cond) { __builtin_amdgcn_s_sleep(1); \
    if ((++_sp & 255u) == 0u) { if (xb_ld(&(bar)[XB_TMO])) break; if (_sp > XB_SPIN_CAP) { atomicAdd(&(bar)[XB_TMO], 1u); break; } } } } while (0)

struct XcdBarrier {
    unsigned* bar; unsigned x;
    volatile LAS unsigned* st;
};

__device__ __forceinline__ XcdBarrier xcd_barrier_post(unsigned* bar, volatile LAS unsigned* st) {
    XcdBarrier b; b.bar = bar; b.x = xb_xcc_id(); b.st = st;
    if (threadIdx.x == 0) (void)xb_add(&bar[XB_XCNT(b.x)], 1u);
    return b;
}
__device__ __forceinline__ void xcd_barrier_complete(unsigned* bar, unsigned x, unsigned& nloc, unsigned& nx) {
    const unsigned G = gridDim.x * gridDim.y * gridDim.z;
    unsigned sum, cnt, mine, sp = 0u;
    for (;;) {
        sum = 0u; cnt = 0u; mine = 0u;
#pragma unroll
        for (unsigned j = 0; j < 16; ++j) { const unsigned c = xb_ld(&bar[XB_XCNT(j)]); sum += c; cnt += (c > 0u) ? 1u : 0u; mine = (j == x) ? c : mine; }
        if (sum == G) break;
        __builtin_amdgcn_s_sleep(1);
        if ((++sp & 255u) == 0u) { if (xb_ld(&bar[XB_TMO])) break; if (sp > XB_SPIN_CAP) { atomicAdd(&bar[XB_TMO], 1u); break; } }
    }
    nloc = mine > 0u ? mine : 1u; nx = cnt > 0u ? cnt : 1u;
}

__device__ __forceinline__ void xcd_barrier(const XcdBarrier& b) {
    asm volatile("s_waitcnt vmcnt(0)" ::: "memory");
    __syncthreads();
    if (threadIdx.x == 0) {
        unsigned* bar = b.bar;
        __builtin_amdgcn_s_waitcnt(0);
        unsigned nloc = b.st[0], nx = b.st[1];
        if (nloc == 0u) { xcd_barrier_complete(bar, b.x, nloc, nx); b.st[0] = nloc; b.st[1] = nx; }
        const unsigned old = xb_add(&bar[XB_XSUB(b.x)], 1u);
        const unsigned gen = old / nloc;
        if (old + 1u == (gen + 1u) * nloc) {
            __builtin_amdgcn_fence(__ATOMIC_RELEASE, "agent");
            asm volatile("s_waitcnt vmcnt(0)" ::: "memory");
            const unsigned og = xb_add(&bar[XB_TOP], 1u);
            const unsigned tg = og / nx;
            if (og + 1u == (tg + 1u) * nx) xb_add(&bar[XB_TOPGEN], 1u);
            else XB_SPIN(xb_ld(&bar[XB_TOPGEN]) == tg, bar);
            __builtin_amdgcn_fence(__ATOMIC_ACQUIRE, "agent");
            xb_add(&bar[XB_XGEN(b.x)], 1u);
            asm volatile("s_waitcnt vmcnt(0)" ::: "memory");
        } else {
            XB_SPIN(xb_ld(&bar[XB_XGEN(b.x)]) == gen, bar);
            __builtin_amdgcn_fence(__ATOMIC_ACQUIRE, "agent");
            asm volatile("s_waitcnt vmcnt(0)" ::: "memory");
        }
    }
    __syncthreads();
}
typedef unsigned short bf16_t;
typedef float f32x4 __attribute__((ext_vector_type(4)));
typedef unsigned u32x4 __attribute__((ext_vector_type(4)));
typedef unsigned u32x2 __attribute__((ext_vector_type(2)));
#define LDS_WAIT() asm volatile("s_waitcnt lgkmcnt(0)" ::: "memory")
__device__ __forceinline__ unsigned f2bf(float f) { unsigned u = __builtin_bit_cast(unsigned, f); return (u + 0x7fffu + ((u >> 16) & 1u)) >> 16; }
__device__ __forceinline__ unsigned pk2(float lo, float hi) { return f2bf(lo) | (f2bf(hi) << 16); }
__device__ __forceinline__ float bf2f(unsigned short h) { return __builtin_bit_cast(float, (unsigned)h << 16); }
__device__ __forceinline__ float wave_sum(float v) {
#pragma unroll
    for (int o = 1; o < 64; o <<= 1) v += __shfl_xor(v, o);
    return v;
}
struct Args { const float* in[27]; float* out; unsigned char* ws; };
enum { I_X = 0, I_C, I_CTX, I_CCTX, I_WMOD, I_BMOD, I_NORMG, I_WG, I_WU, I_WDN, I_AIN, I_AQN, I_AKVN, I_AUQ, I_AUKV, I_AOUT, I_BQKV, I_BLQ1, I_BLK1, I_BLQ2, I_BLK2, I_BSUB, I_BOUT, I_CQKV, I_CRPB, I_COUT, I_FING };

__device__ __forceinline__ void tr_item(const float* W, int Nsrc, int K, int k0, int srccol0, bf16_t* WT, int g0, LAS float* scr, int lane) {
    if (srccol0 >= 0) {
        float v[32];
        const float* wp = W + (size_t)(k0 + (lane >> 5)) * Nsrc + srccol0 + (lane & 31);
#pragma unroll
        for (int i = 0; i < 32; ++i) v[i] = wp[(size_t)(2 * i) * Nsrc];
#pragma unroll
        for (int i = 0; i < 32; ++i) { const int kk = 2 * i + (lane >> 5); scr[kk * 33 + (lane & 31)] = v[i]; }
    } else {
#pragma unroll 8
        for (int i = 0; i < 32; ++i) { const int kk = 2 * i + (lane >> 5); scr[kk * 33 + (lane & 31)] = 0.f; }
    }
    LDS_WAIT(); asm volatile("" ::: "memory");
    const int c = lane & 7;
#pragma unroll
    for (int j = 0; j < 4; ++j) { const int n = (lane >> 3) + 8 * j; const LAS float* s = scr + (8 * c) * 33 + n;
        u32x4 o; o.x = pk2(s[0 * 33], s[1 * 33]); o.y = pk2(s[2 * 33], s[3 * 33]); o.z = pk2(s[4 * 33], s[5 * 33]); o.w = pk2(s[6 * 33], s[7 * 33]);
        *(u32x4*)(WT + (size_t)(g0 + n) * K + k0 + 8 * c) = o; }
    LDS_WAIT(); asm volatile("" ::: "memory");
}

struct PrepItem { const float* W; int Nsrc, K, k0, src; bf16_t* WT; int g0; };
__device__ __forceinline__ PrepItem prep_decode(const Args& A, int r) {
    unsigned char* ws = A.ws; PrepItem t;
    constexpr int IT_GU = 16 * 176, IT_D = 44 * 32, IT_FFN = IT_GU + IT_D;
    constexpr int IT_AIN = 16 * 16, IT_AUQ = 4 * 48, IT_AUKV = 2 * 64, IT_AOUT = 16 * 32, IT_MLA = IT_AIN + IT_AUQ + IT_AUKV + IT_AOUT;
    constexpr int IT_QKV = 16 * 96, IT_OUT = 16 * 32;
    if (r < 8 * IT_FFN) {
        const int fi = r / IT_FFN; r -= fi * IT_FFN;
        if (r < IT_GU) { const int kb = r / 176, gb = r % 176, g = 32 * gb, pn = g >> 8, bj = (g >> 7) & 1, o = g & 127;
            t = PrepItem{(bj ? A.in[I_WU] : A.in[I_WG]) + (size_t)fi * 1024 * DFF, DFF, 1024, 64 * kb, 128 * pn + o, (bf16_t*)(ws + O_WGU + fi * SZ_WGU), g}; }
        else { r -= IT_GU; const int kb = r / 32, gb = r % 32;
            t = PrepItem{A.in[I_WDN] + (size_t)fi * DFF * 1024, 1024, DFF, 64 * kb, 32 * gb, (bf16_t*)(ws + O_WD + fi * SZ_WD), 32 * gb}; }
        return t;
    }
    r -= 8 * IT_FFN;
    if (r < 2 * IT_MLA) {
        const int j = r / IT_MLA; r -= j * IT_MLA;
        if (r < IT_AIN) { const int kb = r / 16, gb = r % 16, g = 32 * gb;
            return PrepItem{A.in[I_AIN] + (size_t)j * 1024 * 448, 448, 1024, 64 * kb, g < 448 ? g : -1, (bf16_t*)(ws + O_AIN + (size_t)j * 512 * 1024 * 2), g}; }
        r -= IT_AIN;
        if (r < IT_AUQ) { const int kb = r / 48, gb = r % 48, g = 32 * gb; int col;
            if (g < 1024) col = (g >> 7) * 192 + (g & 127);
            else { const int g2 = g - 1024, p = g2 >> 8, half = (g2 >> 7) & 1, hh = (g2 >> 5) & 3; col = (4 * p + hh) * 192 + 128 + 32 * half; }
            return PrepItem{A.in[I_AUQ] + (size_t)j * 256 * 1536, 1536, 256, 64 * kb, col, (bf16_t*)(ws + O_AUQ + (size_t)j * 1536 * 256 * 2), g}; }
        r -= IT_AUQ;
        if (r < IT_AUKV) { const int kb = r / 64, gb = r % 64;
            return PrepItem{A.in[I_AUKV] + (size_t)j * 128 * 2048, 2048, 128, 64 * kb, 32 * gb, (bf16_t*)(ws + O_AUKV + (size_t)j * 2048 * 128 * 2), 32 * gb}; }
        r -= IT_AUKV;
        { const int kb = r / 32, gb = r % 32;
            return PrepItem{A.in[I_AOUT] + (size_t)j * 1024 * 1024, 1024, 1024, 64 * kb, 32 * gb, (bf16_t*)(ws + O_AOUT + (size_t)j * 1024 * 1024 * 2), 32 * gb}; }
    }
    r -= 2 * IT_MLA;
    if (r < IT_QKV) { const int kb = r / 96, gb = r % 96, g = 32 * gb; int col = g;
        if (g < 2048) { const int pn = g >> 8, half = (g >> 7) & 1, hh = (g >> 5) & 3; col = 256 * pn + 64 * hh + 32 * half; }
        return PrepItem{A.in[I_BQKV], 3072, 1024, 64 * kb, col, (bf16_t*)(ws + O_BQKV), g}; }
    r -= IT_QKV;
    if (r < IT_OUT) { const int kb = r / 32, gb = r % 32; return PrepItem{A.in[I_BOUT], 1024, 1024, 64 * kb, 32 * gb, (bf16_t*)(ws + O_BOUT), 32 * gb}; }
    r -= IT_OUT;
    if (r < IT_QKV) { const int kb = r / 96, gb = r % 96; return PrepItem{A.in[I_CQKV], 3072, 1024, 64 * kb, 32 * gb, (bf16_t*)(ws + O_CQKV), 32 * gb}; }
    r -= IT_QKV;
    { const int kb = r / 32, gb = r % 32; return PrepItem{A.in[I_COUT], 1024, 1024, 64 * kb, 32 * gb, (bf16_t*)(ws + O_COUT), 32 * gb}; }
}
__device__ __forceinline__ void prep_load(const PrepItem& t, float (&x)[32], int lane) {
    if (t.src >= 0) { const float* wp = t.W + (size_t)(t.k0 + (lane >> 5)) * t.Nsrc + t.src + (lane & 31);
#pragma unroll
        for (int i = 0; i < 32; ++i) x[i] = wp[(size_t)(2 * i) * t.Nsrc]; }
    else {
#pragma unroll
        for (int i = 0; i < 32; ++i) x[i] = 0.f; }
}
__device__ __forceinline__ void prep_finish(const PrepItem& t, const float (&x)[32], LAS float* scr, int lane) {
#pragma unroll
    for (int i = 0; i < 32; ++i) { const int kk = 2 * i + (lane >> 5); scr[kk * 33 + (lane & 31)] = x[i]; }
    LDS_WAIT(); asm volatile("" ::: "memory");
    const int c = lane & 7;
#pragma unroll
    for (int j = 0; j < 4; ++j) { const int n = (lane >> 3) + 8 * j; const LAS float* sp = scr + (8 * c) * 33 + n;
        u32x4 o; o.x = pk2(sp[0 * 33], sp[1 * 33]); o.y = pk2(sp[2 * 33], sp[3 * 33]); o.z = pk2(sp[4 * 33], sp[5 * 33]); o.w = pk2(sp[6 * 33], sp[7 * 33]);
        *(u32x4*)(t.WT + (size_t)(t.g0 + n) * t.K + t.k0 + 8 * c) = o; }
    LDS_WAIT(); asm volatile("" ::: "memory");
}
__device__ __forceinline__ void prep_weights(const Args& A, LAS float* scr, int gw, int NGW, int lane, int a0, int alen, int b0, int vbeg, int vend) {
    int v = vbeg + gw;
    if (v >= vend) return;
    PrepItem cur = prep_decode(A, v < alen ? a0 + v : b0 + (v - alen)); float xc[32];
    prep_load(cur, xc, lane);
    for (;;) {
        const int vn = v + NGW; const bool has = vn < vend; PrepItem nx = cur; float xn[32];
        if (has) { nx = prep_decode(A, vn < alen ? a0 + vn : b0 + (vn - alen)); prep_load(nx, xn, lane); }
        prep_finish(cur, xc, scr, lane);
        if (!has) break;
        cur = nx; v = vn;
#pragma unroll
        for (int i = 0; i < 32; ++i) xc[i] = xn[i];
    }
}

enum { K_NOP = 0, K_NORM, K_GEMM_B, K_GEMM_F, K_MLAMID, K_ATT_A, K_ATT_B, K_ATT_C, K_DIFFFIN, K_FINAL };

__global__ void __launch_bounds__(512, 2) fwd_mega(Args args) {
    extern __shared__ __attribute__((aligned(16))) unsigned char lds_raw[];
    cg::grid_group grid = cg::this_grid();
    LAS unsigned char* lds = (LAS unsigned char*)lds_raw;
    const int tid = threadIdx.x, lane = tid & 63, wave = __builtin_amdgcn_readfirstlane(tid >> 6);
    const int G = gridDim.x, bid = blockIdx.x;
    const int gw = bid * 8 + wave, NGW = G * 8;
    unsigned char* ws = args.ws;
    float* MOD = (float*)(ws + O_MOD); float* ROPE = (float*)(ws + O_ROPE); float* S = (float*)(ws + O_S);

    volatile LAS unsigned* MISC = (volatile LAS unsigned*)(lds + LDS_MISC);
    if (threadIdx.x < 64) MISC[threadIdx.x] = 0u;
    __syncthreads();
    XcdBarrier xbar = xcd_barrier_post((unsigned*)(ws + O_CTL), MISC + 8);
    if (threadIdx.x == 0) MISC[16] = __hip_atomic_fetch_add((unsigned*)(ws + O_CTL) + 3584 + 64 * xbar.x, 1u, __ATOMIC_RELAXED, __HIP_MEMORY_SCOPE_AGENT);
#ifndef PROBE_DUP
#define PROBE_DUP 0
#endif
    for (int p0rep = 0; p0rep < ((PROBE_DUP & 64) ? 2 : 1); ++p0rep) {
        int tid_ = threadIdx.x; asm volatile("" : "+v"(tid_)); const int tid = tid_, lane = tid & 63;
        LAS float* sc = (LAS float*)lds;
        for (int i = tid; i < 3072; i += 512) { const int mi = i >> 10, k = i & 1023; const float v = mi < 2 ? args.in[I_C][mi * 1024 + k] : args.in[I_CCTX][k]; sc[i] = v / (1.f + __expf(-v)); }
        __syncthreads();
        LAS float* red = (LAS float*)(lds + 16384);
        const int cl = tid & 15, kg = tid >> 4;
        for (int item = bid; item < 576; item += G) {
            const int l = item / 144, n0 = (item % 144) * 64;
            const float* W = args.in[I_WMOD] + (size_t)l * 1024 * 9216 + n0 + 4 * cl;
            f32x4 a0 = {0.f, 0.f, 0.f, 0.f}, a1 = a0, a2 = a0;
#pragma unroll 8
            for (int kk = 0; kk < 32; ++kk) { const int k = kg * 32 + kk; const f32x4 w = *(const f32x4*)(W + (size_t)k * 9216); a0 += sc[k] * w; a1 += sc[1024 + k] * w; a2 += sc[2048 + k] * w; }
            *(LAS f32x4*)(red + (kg * 3 + 0) * 64 + 4 * cl) = a0; *(LAS f32x4*)(red + (kg * 3 + 1) * 64 + 4 * cl) = a1; *(LAS f32x4*)(red + (kg * 3 + 2) * 64 + 4 * cl) = a2;
            __syncthreads();
            if (tid < 192) { const int mi = tid >> 6, col = tid & 63; float s = args.in[I_BMOD][l * 9216 + n0 + col];
                for (int k2 = 0; k2 < 32; ++k2) s += red[(k2 * 3 + mi) * 64 + col];
                MOD[(size_t)(l * 3 + mi) * 9216 + n0 + col] = s; }
            __syncthreads();
        }
        prep_weights(args, (LAS float*)(lds + wave * 16384), gw, NGW, lane, 0, 8448, 33792, 0, 8448 + 1088);
        { const int idx = bid * 512 + tid; if (idx < 2048) { const int pos = idx >> 4, m = idx & 15;
#ifndef DIS_ROPE
 const float inv = powf(10000.0f, -(float)m / 16.0f); const float ang = (float)pos * inv; ROPE[idx] = cosf(ang); ROPE[2048 + idx] = sinf(ang);
#endif
 } }
    }
    xcd_barrier(xbar);
    if (args.ws == nullptr) grid.sync();
    int vcu = bid;
    {
        bool even = (G % 8) == 0;
        for (int j = 0; j < 8; ++j) even = even && (__hip_atomic_load((unsigned*)(ws + O_CTL) + 3584 + 64 * j, __ATOMIC_RELAXED, __HIP_MEMORY_SCOPE_AGENT) == (unsigned)(G / 8));
        if (even && xbar.x < 8u) vcu = (int)xbar.x + 8 * (int)MISC[16];
    }

    bool second = false;
    for (int ph = 0; ph < DEPTH * 13 + 1; ++ph) {
        int kind = K_NOP; bool sync_after = true;
        const int L = ph / 13, st = ph - L * 13, mk = L % 3, mj = L / 3;
        unsigned char* ws = args.ws; asm volatile("" : "+s"(ws));
        float* S = (float*)(ws + O_S); bf16_t* H = (bf16_t*)(ws + O_H); unsigned char* X = ws + O_X;
        float* MOD = (float*)(ws + O_MOD); float* ROPE = (float*)(ws + O_ROPE);
        int tid_ = threadIdx.x; asm volatile("" : "+v"(tid_));
        const int tid = tid_, lane = tid & 63, wave = __builtin_amdgcn_readfirstlane(tid >> 6);
        const int gw = bid * 8 + wave, NGW = G * 8;
        size_t aoff = 0, boff = 0; int gN = 0, gK = 0, emode = 0, modoff = 0;
        int nslot = 0, pnsp = 0, pmodoff = 0; float pcoef = 0.f;
        const float* modL = MOD + (size_t)L * 3 * 9216;
        if (ph == DEPTH * 13) kind = K_FINAL;
        else if (st == 0 || st == 3 || st == 10) { kind = K_NORM; nslot = st == 0 ? 0 : (st == 3 ? 1 : 2);
            if (st == 0) { pnsp = L > 0 ? 11 : 0; pmodoff = (L - 1) * 3 * 9216 + 8 * 1024; pcoef = 0.5f; }
            else if (st == 3) { pnsp = 11; pmodoff = L * 3 * 9216 + 2 * 1024; pcoef = 0.5f; }
            else { pnsp = (L == DEPTH - 1) ? 0 : 4; pmodoff = L * 3 * 9216 + 5 * 1024; pcoef = 1.0f; } }
        else if (st == 1 || st == 11) { kind = K_GEMM_B; aoff = O_H; boff = O_WGU + (size_t)(L * 2 + (st == 11)) * SZ_WGU; gN = 5632; gK = 1024; emode = 0; }
        else if (st == 2 || st == 12) { kind = K_GEMM_F; aoff = O_X; boff = O_WD + (size_t)(L * 2 + (st == 12)) * SZ_WD; gN = 1024; gK = DFF; emode = 0; modoff = L * 3 * 9216 + (st == 2 ? 2 : 8) * 1024; }
        else if (mk == 0) {
            if (st == 4) { kind = K_GEMM_F; aoff = O_H; boff = O_AIN + (size_t)mj * 512 * 1024 * 2; gN = 512; gK = 1024; emode = 1; }
            else if (st == 5) kind = K_MLAMID;
            else if (st == 6) { kind = K_GEMM_B; aoff = O_X + XA_CQN; boff = O_AUQ + (size_t)mj * 1536 * 256 * 2; gN = 1536; gK = 256; emode = 4; sync_after = false; }
            else if (st == 7) { kind = K_GEMM_B; aoff = O_X + XA_CKVN; boff = O_AUKV + (size_t)mj * 2048 * 128 * 2; gN = 2048; gK = 128; emode = 3; }
            else if (st == 8) kind = K_ATT_A;
            else if (st == 9) { kind = K_GEMM_F; aoff = O_X + XA_O; boff = O_AOUT + (size_t)mj * 1024 * 1024 * 2; gN = 1024; gK = 1024; emode = 2; modoff = L * 3 * 9216 + 5 * 1024; }
        } else if (mk == 1) {
            if (st == 4) { kind = K_GEMM_B; aoff = O_H; boff = O_BQKV; gN = 3072; gK = 1024; emode = 2; }
            else if (st == 5) kind = K_ATT_B;
            else if (st == 6) kind = K_DIFFFIN;
            else if (st == 7) { kind = K_GEMM_F; aoff = O_X + XB_OUTA; boff = O_BOUT; gN = 1024; gK = 1024; emode = 2; modoff = L * 3 * 9216 + 5 * 1024; }
        } else {
            if (st == 4) { kind = K_GEMM_B; aoff = O_H; boff = O_CQKV; gN = 3072; gK = 1024; emode = 1; }
            else if (st == 5) kind = K_ATT_C;
            else if (st == 6) { kind = K_GEMM_F; aoff = O_X + XB_O2; boff = O_COUT; gN = 1024; gK = 1024; emode = 2; modoff = L * 3 * 9216 + 5 * 1024; }
        }
        if (kind == K_NOP) continue;
#ifndef PROBE_DUP
#define PROBE_DUP 0
#endif
        bool dup = false;
        if ((PROBE_DUP & 1) && (kind == K_ATT_A || kind == K_ATT_B || kind == K_ATT_C)) dup = true;
        if ((PROBE_DUP & 4) && kind == K_GEMM_B && emode == 0) dup = true;
        if ((PROBE_DUP & 8) && kind == K_GEMM_B && emode != 0) dup = true;
        if ((PROBE_DUP & 16) && kind == K_ATT_A) dup = true;
        if ((PROBE_DUP & 32) && kind == K_ATT_B) dup = true;
        if ((PROBE_DUP & 128) && kind == K_NORM) dup = true;
        if (second && kind == K_NORM) pnsp = 0;

        if (kind == K_GEMM_B) {
            pg8::Gemm g{(const bf16_t*)(ws + aoff), (const bf16_t*)(ws + boff), MROWS, gN, gK}; pg8::StaticOrder SO; SO.init(MROWS, gN, gK, G, bid); pg8::EpiB eb{emode, ws};
#ifndef DIS_GEMMB
            pg8::gemm_phase<pg8::EpiB, pg8::StaticOrder, true, true>(lds, g, SO, eb);
#endif
            if (emode == 0 && L < DEPTH - 1) {
                const int nwg_ = 66 * (gN / 256), rem_ = nwg_ % G, nid_ = rem_ ? G - rem_ : G, rank_ = rem_ ? bid - rem_ : bid;
                if (rank_ >= 0) {
                    const int Ln = L + 1, blen_ = (Ln == 3) ? 1088 : 2048, b0_ = (Ln == 1) ? 35968 : (Ln == 2 ? 38016 : 34880), n_ = 8448 + blen_;
                    const int vb_ = (st == 1) ? 0 : n_ / 2, ve_ = (st == 1) ? n_ / 2 : n_;
                    prep_weights(args, (LAS float*)(lds + wave * 16384), rank_ * 8 + wave, nid_ * 8, lane, Ln * 8448, 8448, b0_, vb_, ve_);
                }
            }
        } else if (kind == K_GEMM_F) {
            pg8::Gemm g{(const bf16_t*)(ws + aoff), (const bf16_t*)(ws + boff), MROWS, gN, gK}; pg8::SplitOrder SO; SO.init(gN, gK, G, bid, emode != 1, !(L == DEPTH - 1 && st >= 9));   pg8::EpiF ef{emode, ws, modoff};
#ifndef DIS_GEMMF
            pg8::gemm_phase<pg8::EpiF, pg8::SplitOrder, true, true>(lds, g, SO, ef);
#endif
        } else if (kind == K_NORM) {
            const float* gv = args.in[I_NORMG] + (size_t)(L * 3 + nslot) * 1024;
            for (int row = gw; row < MROWS; row += NGW) {
                const int b = row / TPB, j = row - b * TPB, mi = j < CTXL ? 2 : b;
                const float* sh = modL + (size_t)mi * 9216 + (nslot * 3) * 1024; const float* scl = sh + 1024;
                const bool first = (ph == 0);
                const float* srcrow = first ? (j < CTXL ? args.in[I_CTX] + (size_t)(b * CTXL + j) * 1024 : args.in[I_X] + (size_t)(b * SEQ + j - CTXL) * 1024) : S + (size_t)row * 1024;
                const f32x4* xr = (const f32x4*)srcrow + lane;
                f32x4 v[4]; float ss = 0.f;
#pragma unroll
                for (int q = 0; q < 4; ++q) v[q] = xr[64 * q];
                if (first) { f32x4* xw0 = (f32x4*)(S + (size_t)row * 1024) + lane;
#pragma unroll
                    for (int q = 0; q < 4; ++q) xw0[64 * q] = v[q]; }
                if (pnsp > 0 && j < CTXL) {
                    const f32x4* pp = (const f32x4*)((const float*)(ws + O_P) + (size_t)(b * 256 + j) * 1024) + lane;
                    const f32x4* gm = (const f32x4*)(MOD + pmodoff + 2 * 9216) + lane;
                    f32x4 a4[4];
#pragma unroll
                    for (int q = 0; q < 4; ++q) a4[q] = (f32x4){0.f, 0.f, 0.f, 0.f};
                    for (int ks = 0; ks < pnsp; ++ks) {
#pragma unroll
                        for (int q = 0; q < 4; ++q) a4[q] += pp[(size_t)ks * 512 * 256 + 64 * q];
                    }
                    f32x4* xw = (f32x4*)(S + (size_t)row * 1024) + lane;
#pragma unroll
                    for (int q = 0; q < 4; ++q) { v[q] += (gm[64 * q] * pcoef) * a4[q]; xw[64 * q] = v[q]; }
                }
#pragma unroll
                for (int q = 0; q < 4; ++q) ss += (v[q].x * v[q].x + v[q].y * v[q].y) + (v[q].z * v[q].z + v[q].w * v[q].w);
                const float rstd = rsqrtf(wave_sum(ss) * (1.f / 1024.f) + RMS_EPS);
                unsigned long long* o8 = (unsigned long long*)(H + (size_t)row * 1024) + lane;
#pragma unroll
                for (int q = 0; q < 4; ++q) {
                    const f32x4 g4 = ((const f32x4*)gv)[lane + 64 * q], s4 = ((const f32x4*)scl)[lane + 64 * q], h4 = ((const f32x4*)sh)[lane + 64 * q];
                    const f32x4 y = (v[q] * rstd) * g4 * (1.0f + s4) + h4;
                    o8[64 * q] = (unsigned long long)pk2(y.x, y.y) | ((unsigned long long)pk2(y.z, y.w) << 32);
                }
            }
        } else if (kind == K_MLAMID) {
            const float* CIN = (const float*)(X + XA_CIN); bf16_t* CQN = (bf16_t*)(X + XA_CQN); bf16_t* CKVN = (bf16_t*)(X + XA_CKVN); bf16_t* Kb = (bf16_t*)(X + XA_K);
            const float* gq = args.in[I_AQN] + mj * 256; const float* gkv = args.in[I_AKVN] + mj * 128;
            for (int row = gw; row < MROWS; row += NGW) {
                const int b = row / TPB, j = row - b * TPB;
                const f32x4* cr = (const f32x4*)(CIN + (size_t)row * 512 + 8 * lane);
                const f32x4 a = cr[0], c = cr[1];
                float ss = (a.x * a.x + a.y * a.y) + (a.z * a.z + a.w * a.w) + (c.x * c.x + c.y * c.y) + (c.z * c.z + c.w * c.w);
                ss += __shfl_xor(ss, 1); ss += __shfl_xor(ss, 2); ss += __shfl_xor(ss, 4); ss += __shfl_xor(ss, 8);
                const float s32 = ss + __shfl_xor(ss, 16);
                f32x4 pa, pc;
#pragma unroll
                for (int e = 0; e < 4; ++e) { pa[e] = __shfl_xor(a[e], 4); pc[e] = __shfl_xor(c[e], 4); }
                if (lane < 32) {
                    const float rstd = rsqrtf(s32 * (1.f / 256.f) + RMS_EPS);
                    const f32x4 g0 = *(const f32x4*)(gq + 8 * lane), g1 = *(const f32x4*)(gq + 8 * lane + 4);
                    const f32x4 y0 = a * rstd * g0, y1 = c * rstd * g1;
                    u32x4 w; w.x = pk2(y0.x, y0.y); w.y = pk2(y0.z, y0.w); w.z = pk2(y1.x, y1.y); w.w = pk2(y1.z, y1.w);
                    *(u32x4*)(CQN + (size_t)row * 256 + 8 * lane) = w;
                } else if (lane < 48) {
                    const float rstd = rsqrtf(ss * (1.f / 128.f) + RMS_EPS); const int l2 = lane - 32;
                    const f32x4 g0 = *(const f32x4*)(gkv + 8 * l2), g1 = *(const f32x4*)(gkv + 8 * l2 + 4);
                    const f32x4 y0 = a * rstd * g0, y1 = c * rstd * g1;
                    u32x4 w; w.x = pk2(y0.x, y0.y); w.y = pk2(y0.z, y0.w); w.z = pk2(y1.x, y1.y); w.w = pk2(y1.z, y1.w);
                    *(u32x4*)(CKVN + (size_t)row * 128 + 8 * l2) = w;
                } else if (lane < 56) {
                    const int l3 = lane - 48; const bool second = l3 >= 4; const int jb = 8 * (l3 & 3);
                    f32x4 y0 = a, y1 = c;
                    if (j >= CTXL) {
                        const int t = j - CTXL; const int pos = (jb < 16) ? (t >> 6) : (t & 63); const float* cp = ROPE + pos * 16 + (jb & 15);
                        const f32x4 c0 = *(const f32x4*)cp, c1 = *(const f32x4*)(cp + 4), s0 = *(const f32x4*)(cp + 2048), s1 = *(const f32x4*)(cp + 2052);
                        if (!second) { y0 = a * c0 - pa * s0; y1 = c * c1 - pc * s1; }
                        else { y0 = pa * s0 + a * c0; y1 = pc * s1 + c * c1; }
                    }
                    const pg8::u32x2e w = pg8::pack8_fp8(y0, y1);
                    unsigned char* kp = (unsigned char*)Kb + (size_t)row * 1536 + 128 + 8 * l3;
#pragma unroll
                    for (int h = 0; h < 8; ++h) *(pg8::u32x2e*)(kp + h * 192) = w;
                }
            }
        } else if (kind == K_ATT_A) {
            const bf16_t* Q = (const bf16_t*)(X + XA_Q); const bf16_t* Kb = (const bf16_t*)(X + XA_K); const bf16_t* Vb = (const bf16_t*)(X + XA_V); bf16_t* O = (bf16_t*)(X + XA_O);
            const float scale = 0.07216878364870322f;
            const int nun = 512 + ((L < DEPTH - 1) ? 16 : 0);
            for (int v = vcu; v < nun; v += G) {
                int b, h, qb, nt;
                if (v < 512) { const int xcd = v & 7, cu = (v >> 3) & 31, pair = xcd + 8 * (v >> 8); b = pair >> 3; h = pair & 7; qb = 1 + cu; nt = 132; }
                else { const int u = v - 512; b = u >> 3; h = u & 7; qb = 0; nt = 4; }
                const size_t rowq = (size_t)b * TPB + 256 * qb;
#ifndef DIS_ATTA
                att::attn_unit_f8s((const unsigned char*)Q + rowq * 1536 + h * 192, (const unsigned char*)Kb + (size_t)b * TPB * 1536 + h * 192, (const unsigned char*)Vb + (size_t)((b * 8 + h) * 132) * 8192,
                                    O + rowq * 1024 + h * 128, 1024, nt, scale, (char*)lds_raw, lds);
#endif
            }
        } else if (kind == K_ATT_B) {
            const bf16_t* Q = (const bf16_t*)(X + XB_Q); const bf16_t* Kb = (const bf16_t*)(X + XB_K); const bf16_t* Vb = (const bf16_t*)(X + XB_V); bf16_t* O = (bf16_t*)(X + XB_O2);
            for (int v = vcu; v < 1024 + 32; v += G) {
                int b, hq, qb, nt;
                if (v < 1024) { const int xcd = v & 7, cu = (v >> 3) & 31, pair = xcd + 8 * (v >> 8); b = pair >> 4; hq = pair & 15; qb = 1 + cu; nt = 132; }
                else { const int u = v - 1024; b = u >> 4; hq = u & 15; qb = 0; nt = 4; }
                const size_t rowq = (size_t)b * TPB + 256 * qb;
#ifndef DIS_ATTB
                att::attn_unit<64, 128, 0, false>(Q + rowq * 1024 + hq * 64, 1024, Kb + (size_t)b * TPB * 1024 + hq * 64, 1024, Vb + (size_t)b * TPB * 1024 + (hq >> 1) * 128, 1024,
                                                  O + rowq * 2048 + hq * 128, 2048, nt, 0, 0.125f, 0, 0, (char*)lds_raw, lds);
#endif
            }
        } else if (kind == K_ATT_C) {
            const bf16_t* Q = (const bf16_t*)(X + XB_Q); const bf16_t* Kb = (const bf16_t*)(X + XB_K); const bf16_t* Vb = (const bf16_t*)(X + XB_V); bf16_t* O = (bf16_t*)(X + XB_O2);
            float* btab = (float*)(lds_raw + 98304);
            for (int v = vcu; v < 1024 + 32; v += G) {
                int b, h, qb, nt, r0 = 0, krlo = 0;
                if (v < 1024) { const int xcd = v & 7, cu = (v >> 3) & 31, pair = xcd + 8 * (v >> 8); b = pair >> 4; h = pair & 15; qb = 1 + cu; nt = 15; r0 = 4 * cu; krlo = min(max(r0 - 4, 0), 117); }
                else { const int u = v - 1024; b = u >> 4; h = u & 15; qb = 0; nt = 4; }
                for (int i = tid; i < 465; i += 512) btab[i] = args.in[I_CRPB][h * 465 + i] * 8.0f;
                const size_t rowq = (size_t)b * TPB + 256 * qb;
#ifndef DIS_ATTC
                att::attn_unit<64, 64, 0, true>(Q + rowq * 1024 + h * 64, 1024, Kb + (size_t)b * TPB * 1024 + h * 64, 1024, Vb + (size_t)b * TPB * 1024 + h * 64, 1024,
                                                O + rowq * 1024 + h * 64, 1024, nt, 64 * krlo, 0.125f, r0, krlo, (char*)lds_raw, lds);
#endif
            }
        } else if (kind == K_DIFFFIN) {
            const bf16_t* O2 = (const bf16_t*)(X + XB_O2); bf16_t* OA = (bf16_t*)(X + XB_OUTA);
            const float lam_init = 0.8f - 0.6f * 0.7408182206817179f;
            const float d1 = wave_sum(args.in[I_BLQ1][lane] * args.in[I_BLK1][lane]), d2 = wave_sum(args.in[I_BLQ2][lane] * args.in[I_BLK2][lane]);
            const float lam = expf(d1) - expf(d2) + lam_init;
            const float g0 = args.in[I_BSUB][2 * lane] * (1.f - lam_init), g1 = args.in[I_BSUB][2 * lane + 1] * (1.f - lam_init);
            for (int row = gw; row < MROWS; row += NGW) {
                const unsigned* orow = (const unsigned*)(O2 + (size_t)row * 2048);
                unsigned* dst = (unsigned*)(OA + (size_t)row * 1024);
#pragma unroll
                for (int h = 0; h < 8; ++h) {
                    const unsigned w0 = orow[(2 * h) * 64 + lane], w1 = orow[(2 * h + 1) * 64 + lane];
                    const float x0 = bf2f((unsigned short)(w0 & 0xffff)) - lam * bf2f((unsigned short)(w1 & 0xffff));
                    const float x1 = bf2f((unsigned short)(w0 >> 16)) - lam * bf2f((unsigned short)(w1 >> 16));
                    const float rstd = rsqrtf(wave_sum(x0 * x0 + x1 * x1) * (1.f / 128.f) + RMS_EPS);
                    dst[h * 64 + lane] = pk2(x0 * rstd * g0, x1 * rstd * g1);
                }
            }
        } else if (kind == K_FINAL) {
            const float* gv = args.in[I_FING];
            for (int r = gw; r < NBATCH * SEQ; r += NGW) {
                const int b = r / SEQ, t = r - b * SEQ; const size_t row = (size_t)b * TPB + CTXL + t;
                const f32x4* xr = (const f32x4*)(S + row * 1024) + lane;
                f32x4 v[4]; float ss = 0.f;
#pragma unroll
                for (int q = 0; q < 4; ++q) { v[q] = xr[64 * q]; ss += (v[q].x * v[q].x + v[q].y * v[q].y) + (v[q].z * v[q].z + v[q].w * v[q].w); }
                const float rstd = rsqrtf(wave_sum(ss) * (1.f / 1024.f) + RMS_EPS);
                f32x4* o4 = (f32x4*)(args.out + (size_t)r * 1024) + lane;
#pragma unroll
                for (int q = 0; q < 4; ++q) o4[64 * q] = (v[q] * rstd) * ((const f32x4*)gv)[lane + 64 * q];
            }
        }
        if (sync_after && kind != K_FINAL) { xcd_barrier(xbar); if (PROBE_DUP & 2) xcd_barrier(xbar); }
        if (PROBE_DUP != 0) { if (dup && !second) { second = true; --ph; } else second = false; }
    }
}

extern "C" void kernel_launch(void* const* d_in, const int* in_sizes, int n_in, void* d_out, int out_size, void* d_ws, size_t ws_size, hipStream_t stream) {
    static int grid_blocks = 0;
    if (grid_blocks == 0) {
        if (n_in != 27 || ws_size < WS_NEED) { fprintf(stderr, "kernel_launch: n_in %d (want 27), ws %zu (need %zu)\n", n_in, ws_size, (size_t)WS_NEED); grid_blocks = -1; return; }
        int dev = 0, cus = 0, per_cu = 0;
        hipGetDevice(&dev);
        hipDeviceGetAttribute(&cus, hipDeviceAttributeMultiprocessorCount, dev);
        if (hipFuncSetAttribute((const void*)fwd_mega, hipFuncAttributeMaxDynamicSharedMemorySize, LDS_BYTES) != hipSuccess) { fprintf(stderr, "kernel_launch: hipFuncSetAttribute failed\n"); grid_blocks = -1; return; }
        if (hipOccupancyMaxActiveBlocksPerMultiprocessor(&per_cu, (const void*)fwd_mega, 512, LDS_BYTES) != hipSuccess || per_cu < 1) { fprintf(stderr, "kernel_launch: occupancy query says %d\n", per_cu); per_cu = 1; (void)hipGetLastError(); }
        grid_blocks = cus;
        if (grid_blocks % 8 != 0) grid_blocks = (grid_blocks / 8) * 8;
    }
    if (grid_blocks < 0) return;
    if (hipMemsetAsync((char*)d_ws + O_CTL, 0, CTL_BYTES, stream) != hipSuccess) { fprintf(stderr, "kernel_launch: hipMemsetAsync failed\n"); return; }
    Args a{};
    for (int i = 0; i < 27; ++i) a.in[i] = (const float*)d_in[i];
    a.out = (float*)d_out; a.ws = (unsigned char*)d_ws;
    void* kargs[] = {&a};
    hipError_t e = hipLaunchCooperativeKernel((const void*)fwd_mega, dim3(grid_blocks), dim3(512), kargs, LDS_BYTES, stream);
    if (e != hipSuccess) fprintf(stderr, "cooperative launch failed: %s (grid %d)\n", hipGetErrorString(e), grid_blocks);
}
```
